# Optimizing an MI355X kernel written in HIP

```python
import math
import jax
import jax.numpy as jnp
from jax import lax
import numpy as np

D_MODEL = 1024
BATCH = 32
SEQ = 2048
DEPTH = 4

CTX_LEN = 256
GRID_W = 64
ROPE_BASE = 10000.0
NORM_EPS = 1e-6
NEG_INF = -1e30

MLA_HEADS = 4
MLA_Q_RANK = 192
MLA_KV_RANK = 128
MLA_NOPE = 64
MLA_ROPE = 32
MLA_V = 64
Q_BLOCK = 128
NA_HEADS = 4
NA_DIM = 64
NA_ROWS = 8
NA_COLS = 16
NA_QCB = 16
NA_KBW = 32
S5_GROUPS = 16
S5_GROUP_CH = 16
S5_STATE = 64
S5_WIDTH = S5_GROUPS * S5_GROUP_CH
RET_HEADS = 4
RET_DIM = 64
RET_CHUNK = 128
MLA_WIDTH = MLA_HEADS * MLA_V
NA_WIDTH = NA_HEADS * NA_DIM
RET_WIDTH = RET_HEADS * RET_DIM
MIX_WIDTH = MLA_WIDTH + NA_WIDTH + S5_WIDTH + RET_WIDTH
IN_SPLITS = (MLA_Q_RANK, MLA_KV_RANK, MLA_ROPE, NA_WIDTH, NA_WIDTH, NA_WIDTH, S5_WIDTH,
             RET_WIDTH, RET_WIDTH, RET_WIDTH, RET_WIDTH)
IN_COLS = sum(IN_SPLITS)
MOE_GROUPS = 4
MOE_EXPERTS_PER_GROUP = 8
MOE_EXPERTS = MOE_GROUPS * MOE_EXPERTS_PER_GROUP
MOE_TOP_K = 2
MOE_FF = 512
MOE_BLOCK = 128

F32 = jnp.float32

kernel_name = 'hybrid_parallel_heads_diffusion_trunk'


def rmsnorm(x, g):
    xf = x.astype(F32)
    y = xf * lax.rsqrt(jnp.mean(xf * xf, axis=-1, keepdims=True) + NORM_EPS)
    return y.astype(x.dtype) * g


def split_cols(p):
    return jnp.split(p, list(np.cumsum(IN_SPLITS)[:-1]), axis=-1)


def axial_rope_tables(seq_len, rot_dim):
    t = jnp.arange(seq_len)
    row = (t // GRID_W).astype(F32)
    col = (t % GRID_W).astype(F32)
    half = rot_dim // 2
    inv = 1.0 / (ROPE_BASE ** (jnp.arange(0, half, 2, dtype=F32) / half))
    ar = row[:, None] * inv
    ac = col[:, None] * inv
    ang = jnp.concatenate([ar, ar, ac, ac], axis=-1)
    return jnp.cos(ang), jnp.sin(ang)


def _rotate_half(u):
    u1, u2 = jnp.split(u, 2, axis=-1)
    return jnp.concatenate([-u2, u1], axis=-1)


def apply_axial_rope(x, cos, sin):
    half = x.shape[-1] // 2
    rot = jnp.concatenate([_rotate_half(x[..., :half]), _rotate_half(x[..., half:])], axis=-1)
    return x * cos[None, :, None, :] + rot * sin[None, :, None, :]


def softmax_attention(q, k, v):
    s = jnp.einsum('bqhd,bkhd->bhqk', q, k, preferred_element_type=F32)
    p = jax.nn.softmax(s, axis=-1).astype(v.dtype)
    return jnp.einsum('bhqk,bkhe->bqhe', p, v)


def blocked_attention(q, k, v):
    B, L, H, dk = q.shape
    nb = L // Q_BLOCK
    qb = jnp.moveaxis(q.reshape(B, nb, Q_BLOCK, H, dk), 1, 0)
    out = lax.map(lambda qq: softmax_attention(qq, k, v), qb)
    return jnp.moveaxis(out, 0, 1).reshape(B, L, H, v.shape[-1])


def mla_queries(cq, g_cq, w_uq, cos, sin):
    B, L, _ = cq.shape
    q = (rmsnorm(cq, g_cq) @ w_uq).reshape(B, L, MLA_HEADS, MLA_NOPE + MLA_ROPE)
    q_nope, q_rope = q[..., :MLA_NOPE], q[..., MLA_NOPE:]
    if cos is not None:
        q_rope = apply_axial_rope(q_rope, cos, sin)
    return jnp.concatenate([q_nope, q_rope], axis=-1) * (MLA_NOPE + MLA_ROPE) ** -0.5


def mla_keys_values(ckv, kr, g_ckv, w_ukv, cos, sin):
    B, L, _ = ckv.shape
    kv = (rmsnorm(ckv, g_ckv) @ w_ukv).reshape(B, L, MLA_HEADS, MLA_NOPE + MLA_V)
    k_nope, v = kv[..., :MLA_NOPE], kv[..., MLA_NOPE:]
    k_rope = kr[:, :, None, :]
    if cos is not None:
        k_rope = apply_axial_rope(k_rope, cos, sin)
    k = jnp.concatenate([k_nope, jnp.broadcast_to(k_rope, (B, L, MLA_HEADS, MLA_ROPE))], axis=-1)
    return k, v


def mla_mixer(cq_l, ckv_l, kr_l, cq_c, ckv_c, kr_c, g_cq, g_ckv, w_uq, w_ukv, cos, sin, need_ctx):
    B, L, _ = cq_l.shape
    q_l = mla_queries(cq_l, g_cq, w_uq, cos, sin)
    k_l, v_l = mla_keys_values(ckv_l, kr_l, g_ckv, w_ukv, cos, sin)
    k_c, v_c = mla_keys_values(ckv_c, kr_c, g_ckv, w_ukv, None, None)
    out_l = blocked_attention(q_l, jnp.concatenate([k_l, k_c], axis=1),
                              jnp.concatenate([v_l, v_c], axis=1)).reshape(B, L, MLA_WIDTH)
    out_c = None
    if need_ctx:
        q_c = mla_queries(cq_c, g_cq, w_uq, None, None)
        out_c = softmax_attention(q_c, k_c, v_c).reshape(B, cq_c.shape[1], MLA_WIDTH)
    return out_l, out_c


def natten_mixer(q_l, k_l, v_l, q_c, k_c, v_c, rpb, need_ctx):
    B, L, _ = q_l.shape
    Lc = k_c.shape[1]
    rows = L // GRID_W
    wr = min(NA_ROWS, rows)
    scale = NA_DIM ** -0.5

    def heads(t):
        return t.reshape(t.shape[0], t.shape[1], NA_HEADS, NA_DIM)

    qg = (heads(q_l) * scale).reshape(B, rows, GRID_W, NA_HEADS, NA_DIM)
    kg = heads(k_l).reshape(B, rows, GRID_W, NA_HEADS, NA_DIM)
    vg = heads(v_l).reshape(B, rows, GRID_W, NA_HEADS, NA_DIM)
    kc_h, vc_h = heads(k_c), heads(v_c)
    n_cb = GRID_W // NA_QCB
    q_cols = np.arange(GRID_W).reshape(n_cb, NA_QCB)
    q_start = np.clip(q_cols - NA_COLS // 2, 0, GRID_W - NA_COLS)
    blk_start = np.clip(np.arange(n_cb) * NA_QCB - NA_COLS // 2, 0, GRID_W - NA_KBW)
    key_cols = blk_start[:, None] + np.arange(NA_KBW)
    kcol = key_cols[:, None, :]
    col_valid = (kcol >= q_start[..., None]) & (kcol < q_start[..., None] + NA_COLS)
    dc_idx = np.clip(kcol - q_cols[..., None] + NA_COLS - 1, 0, 2 * NA_COLS - 2)
    bias_cols = jnp.transpose(rpb[:, :, dc_idx], (0, 2, 3, 1, 4))
    valid = col_valid[:, :, None, :]
    n_win = wr * NA_KBW

    def one_row(r):
        rs = jnp.clip(r - wr // 2, 0, rows - wr)
        k_blk = lax.dynamic_slice_in_dim(kg, rs, wr, axis=1)[:, :, key_cols]
        v_blk = lax.dynamic_slice_in_dim(vg, rs, wr, axis=1)[:, :, key_cols]
        q_row = lax.dynamic_index_in_dim(qg, r, axis=1, keepdims=False).reshape(B, n_cb, NA_QCB, NA_HEADS, NA_DIM)
        dr_idx = rs + jnp.arange(wr) - r + NA_ROWS - 1
        bias = jnp.take(bias_cols, dr_idx, axis=3)
        s_win = jnp.einsum('bjqhd,brjkhd->bhjqrk', q_row, k_blk, preferred_element_type=F32) + bias
        s_win = jnp.where(valid, s_win, NEG_INF).reshape(B, NA_HEADS, n_cb, NA_QCB, n_win)
        s_ctx = jnp.einsum('bjqhd,bkhd->bhjqk', q_row, kc_h, preferred_element_type=F32)
        p = jax.nn.softmax(jnp.concatenate([s_win, s_ctx], axis=-1), axis=-1).astype(v_blk.dtype)
        p_win = p[..., :n_win].reshape(B, NA_HEADS, n_cb, NA_QCB, wr, NA_KBW)
        o = (jnp.einsum('bhjqrk,brjkhd->bjqhd', p_win, v_blk)
             + jnp.einsum('bhjqk,bkhd->bjqhd', p[..., n_win:], vc_h))
        return o.reshape(B, GRID_W, NA_WIDTH)

    out_l = jnp.moveaxis(lax.map(one_row, jnp.arange(rows)), 0, 1).reshape(B, L, NA_WIDTH)
    out_c = None
    if need_ctx:
        out_c = softmax_attention(heads(q_c) * scale, kc_h, vc_h).reshape(B, Lc, NA_WIDTH)
    return out_l, out_c


def s5_discretise(a_re, a_im, log_dt, b_re, b_im):
    a_re, a_im = a_re.astype(F32), a_im.astype(F32)
    dt = jnp.exp(log_dt.astype(F32))[:, None]
    ldr, ldi = a_re * dt, a_im * dt
    mag = jnp.exp(ldr)
    abar_re, abar_im = mag * jnp.cos(ldi), mag * jnp.sin(ldi)
    num_re, num_im = abar_re - 1.0, abar_im
    den = a_re * a_re + a_im * a_im
    f_re = (num_re * a_re + num_im * a_im) / den
    f_im = (num_im * a_re - num_re * a_im) / den
    b_re, b_im = b_re.astype(F32), b_im.astype(F32)
    bb_re = f_re[..., None] * b_re - f_im[..., None] * b_im
    bb_im = f_re[..., None] * b_im + f_im[..., None] * b_re
    return abar_re, abar_im, bb_re, bb_im, ldr, ldi


def _complex_affine_combine(left, right):
    a1r, a1i, b1r, b1i = left
    a2r, a2i, b2r, b2i = right
    return (a2r * a1r - a2i * a1i, a2r * a1i + a2i * a1r,
            a2r * b1r - a2i * b1i + b2r, a2r * b1i + a2i * b1r + b2i)


def s5_scan(bu_re, bu_im, abar_re, abar_im, reverse):
    L = bu_re.shape[1]
    a_re = jnp.broadcast_to(abar_re, (1, L) + abar_re.shape)
    a_im = jnp.broadcast_to(abar_im, (1, L) + abar_im.shape)
    return lax.associative_scan(_complex_affine_combine, (a_re, a_im, bu_re, bu_im), reverse=reverse, axis=1)


def s5_readout(h_re, h_im, c_re, c_im):
    return jnp.einsum('blgp,gcp->blgc', h_re, c_re) - jnp.einsum('blgp,gcp->blgc', h_im, c_im)


def s5_mixer(u_l, u_c, a_re, a_im, log_dt, b_re, b_im, c_re, c_im, d_skip, w_glu, b_glu, need_ctx):
    B, L, _ = u_l.shape
    Lc = u_c.shape[1]
    ul_g = u_l.astype(F32).reshape(B, L, S5_GROUPS, S5_GROUP_CH)
    uc_g = u_c.astype(F32).reshape(B, Lc, S5_GROUPS, S5_GROUP_CH)
    y_l, y_c = [], []
    for d in range(2):
        abr, abi, bbr, bbi, ldr, ldi = s5_discretise(a_re[d], a_im[d], log_dt[d], b_re[d], b_im[d])
        cr, ci = c_re[d].astype(F32), c_im[d].astype(F32)
        buc_re = jnp.einsum('blgc,gpc->blgp', uc_g, bbr)
        buc_im = jnp.einsum('blgc,gpc->blgp', uc_g, bbi)
        dist = jnp.arange(Lc, dtype=F32)
        if d == 0:
            dist = (Lc - 1) - dist
        pw_mag = jnp.exp(dist[:, None, None] * ldr)
        pw_re = pw_mag * jnp.cos(dist[:, None, None] * ldi)
        pw_im = pw_mag * jnp.sin(dist[:, None, None] * ldi)
        h0_re = jnp.einsum('lgp,blgp->bgp', pw_re, buc_re) - jnp.einsum('lgp,blgp->bgp', pw_im, buc_im)
        h0_im = jnp.einsum('lgp,blgp->bgp', pw_re, buc_im) + jnp.einsum('lgp,blgp->bgp', pw_im, buc_re)
        bul_re = jnp.einsum('blgc,gpc->blgp', ul_g, bbr)
        bul_im = jnp.einsum('blgc,gpc->blgp', ul_g, bbi)
        pa_re, pa_im, h_re, h_im = s5_scan(bul_re, bul_im, abr, abi, reverse=(d == 1))
        h_re = h_re + pa_re * h0_re[:, None] - pa_im * h0_im[:, None]
        h_im = h_im + pa_re * h0_im[:, None] + pa_im * h0_re[:, None]
        y_l.append(s5_readout(h_re, h_im, cr, ci))
        if need_ctx:
            _, _, hc_re, hc_im = s5_scan(buc_re, buc_im, abr, abi, reverse=(d == 1))
            y_c.append(s5_readout(hc_re, hc_im, cr, ci))

    def finish(ys, u):
        y = (ys[0] + ys[1]).reshape(u.shape) + d_skip * u.astype(F32)
        g = jax.nn.gelu(y)
        return (g * jax.nn.sigmoid(g @ w_glu + b_glu)).astype(u.dtype)

    out_l = finish(y_l, u_l)
    out_c = finish(y_c, u_c) if need_ctx else None
    return out_l, out_c


def retention_chunkwise(q, k, v, lg, r0, strict):
    B, L, H, d = q.shape
    n = L // RET_CHUNK

    def chunks(t):
        return jnp.moveaxis(t.reshape(B, n, RET_CHUNK, H, t.shape[-1]), 1, 0)

    pos = jnp.arange(RET_CHUNK, dtype=F32)
    diff = pos[:, None] - pos[None, :]
    mask = diff > 0 if strict else diff >= 0
    inner_decay = jnp.where(mask[None], jnp.exp(lg[:, None, None] * jnp.maximum(diff, 0.0)[None]), 0.0)
    q_decay = jnp.exp(lg[None, :] * (pos[:, None] + 1.0))[None, :, :, None]
    k_decay = jnp.exp(lg[None, :] * (RET_CHUNK - 1.0 - pos)[:, None])[None, :, :, None]
    chunk_decay = jnp.exp(lg * RET_CHUNK)[None, :, None, None]

    def step(state, inp):
        qc, kc, vc = inp
        s = jnp.einsum('bqhd,bkhd->bhqk', qc, kc) * inner_decay
        inner = jnp.einsum('bhqk,bkhe->bqhe', s, vc)
        cross = jnp.einsum('bqhd,bhde->bqhe', qc, state) * q_decay
        state = state * chunk_decay + jnp.einsum('bkhd,bkhe->bhde', kc * k_decay, vc)
        return state, inner + cross

    _, out = lax.scan(step, r0, (chunks(q), chunks(k), chunks(v)))
    return jnp.moveaxis(out, 0, 1).reshape(B, L, H, v.shape[-1])


def retention_direction(q, k, v, lg, r0, reverse):
    if reverse:
        q, k, v = jnp.flip(q, 1), jnp.flip(k, 1), jnp.flip(v, 1)
        return jnp.flip(retention_chunkwise(q, k, v, lg, r0, strict=True), 1)
    return retention_chunkwise(q, k, v, lg, r0, strict=False)


def retention_context_state(k, v, lg, reverse):
    Lc = k.shape[1]
    dist = jnp.arange(Lc, dtype=F32)
    if not reverse:
        dist = (Lc - 1) - dist
    w = jnp.exp(dist[:, None] * lg[None, :])
    return jnp.einsum('blhd,blhe,lh->bhde', k, v, w)


def head_group_norm(y):
    mu = jnp.mean(y, axis=-1, keepdims=True)
    var = jnp.mean(jnp.square(y - mu), axis=-1, keepdims=True)
    return (y - mu) * lax.rsqrt(var + NORM_EPS)


def retention_mixer(q_l, k_l, v_l, g_l, q_c, k_c, v_c, g_c, log_decay, cos, sin, need_ctx):
    B, L, _ = q_l.shape
    Lc = k_c.shape[1]

    def heads(t):
        return t.astype(F32).reshape(t.shape[0], t.shape[1], RET_HEADS, RET_DIM)

    kscale = RET_DIM ** -0.5
    ql_h = apply_axial_rope(heads(q_l), cos, sin)
    kl_h = apply_axial_rope(heads(k_l), cos, sin) * kscale
    vl_h = heads(v_l)
    kc_h, vc_h = heads(k_c) * kscale, heads(v_c)
    y_l, y_c = [], []
    for d in range(2):
        lg = log_decay[d].astype(F32)
        r0 = retention_context_state(kc_h, vc_h, lg, reverse=(d == 1))
        y_l.append(retention_direction(ql_h, kl_h, vl_h, lg, r0, reverse=(d == 1)))
        if need_ctx:
            zero = jnp.zeros((B, RET_HEADS, RET_DIM, RET_DIM), F32)
            y_c.append(retention_direction(heads(q_c), kc_h, vc_h, lg, zero, reverse=(d == 1)))
    out_l = (jax.nn.silu(g_l.astype(F32)) * head_group_norm(y_l[0] + y_l[1]).reshape(B, L, RET_WIDTH)).astype(q_l.dtype)
    out_c = None
    if need_ctx:
        out_c = (jax.nn.silu(g_c.astype(F32)) * head_group_norm(y_c[0] + y_c[1]).reshape(B, Lc, RET_WIDTH)).astype(q_c.dtype)
    return out_l, out_c


def moe_ffn(h, w_group, b_group, w_expert, b_expert, w1, w3, w2):
    T, D = h.shape
    g_logits = jnp.matmul(h, w_group, preferred_element_type=F32) + b_group
    g_prob = jax.nn.softmax(g_logits, axis=-1)
    g_idx = jnp.argmax(g_logits, axis=-1)
    g_gate = jnp.take_along_axis(g_prob, g_idx[:, None], axis=-1)
    e_logits = (jnp.matmul(h, w_expert, preferred_element_type=F32) + b_expert).reshape(T, MOE_GROUPS, MOE_EXPERTS_PER_GROUP)
    e_logits = jnp.take_along_axis(e_logits, g_idx[:, None, None], axis=1)[:, 0]
    top_p, top_i = lax.top_k(jax.nn.softmax(e_logits, axis=-1), MOE_TOP_K)
    gates = g_gate * top_p / jnp.sum(top_p, axis=-1, keepdims=True)
    expert = g_idx[:, None] * MOE_EXPERTS_PER_GROUP + top_i
    n_pairs = T * MOE_TOP_K
    flat_e = expert.reshape(n_pairs).astype(jnp.int32)
    flat_tok = jnp.repeat(jnp.arange(T, dtype=jnp.int32), MOE_TOP_K)
    flat_w = gates.reshape(n_pairs)
    order = jnp.argsort(flat_e)
    sorted_e = flat_e[order]
    counts = jnp.bincount(flat_e, length=MOE_EXPERTS)
    starts = jnp.cumsum(counts) - counts
    padded = (counts + MOE_BLOCK - 1) // MOE_BLOCK * MOE_BLOCK
    pad_ends = jnp.cumsum(padded)
    pad_starts = pad_ends - padded
    dest = pad_starts[sorted_e] + jnp.arange(n_pairs, dtype=jnp.int32) - starts[sorted_e]
    cap = -(-(n_pairs + MOE_EXPERTS * (MOE_BLOCK - 1)) // MOE_BLOCK) * MOE_BLOCK
    n_blocks = cap // MOE_BLOCK
    slot_tok = jnp.full((cap,), T, jnp.int32).at[dest].set(flat_tok[order])
    slot_w = jnp.zeros((cap,), F32).at[dest].set(flat_w[order])
    h_pad = jnp.concatenate([h, jnp.zeros((1, D), h.dtype)], axis=0)
    buf = h_pad[slot_tok].reshape(n_blocks, MOE_BLOCK, D)
    block_expert = jnp.minimum(jnp.searchsorted(pad_ends, jnp.arange(n_blocks, dtype=jnp.int32) * MOE_BLOCK, side='right'), MOE_EXPERTS - 1)

    def expert_block(args):
        xb, e = args
        return (jax.nn.silu(xb @ w1[e]) * (xb @ w3[e])) @ w2[e]

    y = lax.map(expert_block, (buf, block_expert)).reshape(cap, D)
    return jax.ops.segment_sum(y * slot_w[:, None].astype(y.dtype), slot_tok, num_segments=T + 1)[:T]


def setup_inputs(seed: int = 0) -> dict:
    key = jax.random.key(seed)
    ks = iter(jax.random.split(key, 48))

    def nrm(shape, scale):
        return jax.random.normal(next(ks), shape, F32) * scale

    L, D = DEPTH, D_MODEL
    G, P, CG = S5_GROUPS, S5_STATE, S5_GROUP_CH
    ret_base = jnp.log1p(-(2.0 ** (-5.0 - jnp.arange(RET_HEADS, dtype=F32))))
    return {
        'x': nrm((BATCH, SEQ, D), 1.0),
        'c': nrm((BATCH, D), 1.0),
        'ctx': nrm((BATCH, CTX_LEN, D), 1.0),
        'c_ctx': nrm((D,), 1.0),
        'w_mod': nrm((L, D, 6 * D), 0.5 * D ** -0.5),
        'b_mod': nrm((L, 6 * D), 0.02),
        'g_mix': 1.0 + nrm((L, D), 0.02),
        'g_ffn': 1.0 + nrm((L, D), 0.02),
        'w_in': nrm((L, D, IN_COLS), D ** -0.5),
        'mla_g_cq': 1.0 + nrm((L, MLA_Q_RANK), 0.02),
        'mla_g_ckv': 1.0 + nrm((L, MLA_KV_RANK), 0.02),
        'mla_w_uq': nrm((L, MLA_Q_RANK, MLA_HEADS * (MLA_NOPE + MLA_ROPE)), MLA_Q_RANK ** -0.5),
        'mla_w_ukv': nrm((L, MLA_KV_RANK, MLA_HEADS * (MLA_NOPE + MLA_V)), MLA_KV_RANK ** -0.5),
        'na_rpb': nrm((L, NA_HEADS, 2 * NA_ROWS - 1, 2 * NA_COLS - 1), 0.1),
        's5_a_re': -0.5 * (1.0 + nrm((L, 2, G, P), 0.05)),
        's5_a_im': jnp.pi * jnp.arange(P, dtype=F32) + nrm((L, 2, G, P), 0.05),
        's5_log_dt': jax.random.uniform(next(ks), (L, 2, G), F32, math.log(1e-3), math.log(1e-1)),
        's5_b_re': nrm((L, 2, G, P, CG), (2.0 * CG) ** -0.5),
        's5_b_im': nrm((L, 2, G, P, CG), (2.0 * CG) ** -0.5),
        's5_c_re': nrm((L, 2, G, CG, P), (2.0 * P) ** -0.5),
        's5_c_im': nrm((L, 2, G, CG, P), (2.0 * P) ** -0.5),
        's5_d': nrm((L, S5_WIDTH), 1.0),
        's5_w_glu': nrm((L, S5_WIDTH, S5_WIDTH), S5_WIDTH ** -0.5),
        's5_b_glu': nrm((L, S5_WIDTH), 0.02),
        'ret_log_decay': ret_base * (1.0 + nrm((L, 2, RET_HEADS), 0.05)),
        'w_out': nrm((L, MIX_WIDTH, D), MIX_WIDTH ** -0.5),
        'moe_w_group': nrm((L, D, MOE_GROUPS), D ** -0.5),
        'moe_b_group': nrm((L, MOE_GROUPS), 0.01),
        'moe_w_expert': nrm((L, D, MOE_EXPERTS), D ** -0.5),
        'moe_b_expert': nrm((L, MOE_EXPERTS), 0.01),
        'moe_w1': nrm((L, MOE_EXPERTS, D, MOE_FF), D ** -0.5),
        'moe_w3': nrm((L, MOE_EXPERTS, D, MOE_FF), D ** -0.5),
        'moe_w2': nrm((L, MOE_EXPERTS, MOE_FF, D), MOE_FF ** -0.5),
        'g_final': 1.0 + nrm((D,), 0.02),
    }


def reference(x, c, ctx, c_ctx, w_mod, b_mod, g_mix, g_ffn, w_in, mla_g_cq, mla_g_ckv, mla_w_uq, mla_w_ukv,
              na_rpb, s5_a_re, s5_a_im, s5_log_dt, s5_b_re, s5_b_im, s5_c_re, s5_c_im, s5_d, s5_w_glu, s5_b_glu,
              ret_log_decay, w_out, moe_w_group, moe_b_group, moe_w_expert, moe_b_expert, moe_w1, moe_w3, moe_w2,
              g_final):
    B, S, D = x.shape
    cos_m, sin_m = axial_rope_tables(S, MLA_ROPE)
    cos_r, sin_r = axial_rope_tables(S, RET_DIM)
    c_act = jax.nn.silu(c)
    cc_act = jax.nn.silu(c_ctx)
    xl, xc = x, ctx
    for layer in range(DEPTH):
        need_ctx = layer < DEPTH - 1
        sh1, sc1, gt1, sh2, sc2, gt2 = [m[:, None, :] for m in jnp.split(c_act @ w_mod[layer] + b_mod[layer], 6, axis=-1)]
        csh1, csc1, cgt1, csh2, csc2, cgt2 = jnp.split(cc_act @ w_mod[layer] + b_mod[layer], 6, axis=-1)
        hl = rmsnorm(xl, g_mix[layer]) * (1.0 + sc1) + sh1
        hc = rmsnorm(xc, g_mix[layer]) * (1.0 + csc1) + csh1
        pl = split_cols(hl @ w_in[layer])
        pc = split_cols(hc @ w_in[layer])
        a_l, a_c = mla_mixer(pl[0], pl[1], pl[2], pc[0], pc[1], pc[2], mla_g_cq[layer], mla_g_ckv[layer],
                             mla_w_uq[layer], mla_w_ukv[layer], cos_m, sin_m, need_ctx)
        n_l, n_c = natten_mixer(pl[3], pl[4], pl[5], pc[3], pc[4], pc[5], na_rpb[layer], need_ctx)
        s_l, s_c = s5_mixer(pl[6], pc[6], s5_a_re[layer], s5_a_im[layer], s5_log_dt[layer], s5_b_re[layer],
                            s5_b_im[layer], s5_c_re[layer], s5_c_im[layer], s5_d[layer], s5_w_glu[layer],
                            s5_b_glu[layer], need_ctx)
        r_l, r_c = retention_mixer(pl[7], pl[8], pl[9], pl[10], pc[7], pc[8], pc[9], pc[10], ret_log_decay[layer],
                                   cos_r, sin_r, need_ctx)
        xl = xl + gt1 * (jnp.concatenate([a_l, n_l, s_l, r_l], axis=-1) @ w_out[layer])
        if need_ctx:
            xc = xc + cgt1 * (jnp.concatenate([a_c, n_c, s_c, r_c], axis=-1) @ w_out[layer])
        fl = rmsnorm(xl, g_ffn[layer]) * (1.0 + sc2) + sh2
        moe_w = (moe_w_group[layer], moe_b_group[layer], moe_w_expert[layer], moe_b_expert[layer],
                 moe_w1[layer], moe_w3[layer], moe_w2[layer])
        if need_ctx:
            fc = rmsnorm(xc, g_ffn[layer]) * (1.0 + csc2) + csh2
            y = moe_ffn(jnp.concatenate([fl.reshape(-1, D), fc.reshape(-1, D)], axis=0), *moe_w)
            xl = xl + gt2 * y[:B * S].reshape(B, S, D)
            xc = xc + cgt2 * y[B * S:].reshape(xc.shape)
        else:
            xl = xl + gt2 * moe_ffn(fl.reshape(-1, D), *moe_w).reshape(B, S, D)
    return rmsnorm(xl, g_final)
```

```cpp
#include <hip/hip_runtime.h>
#include <stdint.h>

typedef unsigned short bf16_t;
typedef short bf16x8 __attribute__((ext_vector_type(8)));
typedef float f32x4 __attribute__((ext_vector_type(4)));
typedef float f32x16 __attribute__((ext_vector_type(16)));
typedef unsigned u32x4 __attribute__((ext_vector_type(4)));
typedef unsigned u32x2 __attribute__((ext_vector_type(2)));

#define D_MODEL 1024
#define BATCH 32
#define SEQ 2048
#define DEPTH 4
#define CTXL 256
#define TL (BATCH * SEQ)
#define TC (BATCH * CTXL)
#define TT (TL + TC)
#define SEQA (SEQ + CTXL)
#define IN_COLS 2400
#define PLD 2432
#define PC_CQ 0
#define PC_KR 192
#define PC_CKV 256
#define PC_NAQ 384
#define PC_NAK 640
#define PC_NAV 896
#define PC_U 1152
#define PC_RQ 1408
#define PC_RK 1664
#define PC_RV 1920
#define PC_RG 2176
#define NEXP 32
#define MOE_FF 512
#define CAP_ROWS 155648
#define WIN_N 2560
#define S5CH 32
#define S5NCH 72

#define XB_TMO      128
#define XB_XCNT(j)  (256  + 64 * (j))
#define XB_XSUB(j)  (1280 + 64 * (j))
#define XB_XGEN(j)  (2304 + 64 * (j))
#define XB_TOP      3328
#define XB_TOPGEN   3392
#define XCD_BAR_WORDS 3456
#define XB_SPIN_CAP (1u << 22)
#define LAS __attribute__((address_space(3)))

__device__ __forceinline__ unsigned xb_ld(unsigned* p)              { return __hip_atomic_load(p, __ATOMIC_RELAXED, __HIP_MEMORY_SCOPE_AGENT); }
__device__ __forceinline__ unsigned xb_add(unsigned* p, unsigned v) { return __hip_atomic_fetch_add(p, v, __ATOMIC_RELAXED, __HIP_MEMORY_SCOPE_AGENT); }
__device__ __forceinline__ unsigned xb_xcc_id() { return (unsigned)__builtin_amdgcn_s_getreg((3 << 11) | 20) & 0xFu; }
#define XB_SPIN(cond, bar) do { unsigned _sp = 0; while (cond) { __builtin_amdgcn_s_sleep(1); \
    if ((++_sp & 255u) == 0u) { if (xb_ld(&(bar)[XB_TMO])) break; if (_sp > XB_SPIN_CAP) { atomicAdd(&(bar)[XB_TMO], 1u); break; } } } } while (0)

struct XcdBarrier { unsigned* bar; unsigned x; volatile LAS unsigned* st; };

__device__ __forceinline__ XcdBarrier xcd_barrier_post(unsigned* bar, volatile LAS unsigned* st) {
    XcdBarrier b; b.bar = bar; b.x = xb_xcc_id(); b.st = st;
    if (threadIdx.x == 0) (void)xb_add(&bar[XB_XCNT(b.x)], 1u);
    return b;
}
__device__ __forceinline__ void xcd_barrier_complete(unsigned* bar, unsigned x, unsigned& nloc, unsigned& nx) {
    const unsigned G = gridDim.x * gridDim.y * gridDim.z;
    unsigned sum, cnt, mine, sp = 0u;
    for (;;) {
        sum = 0u; cnt = 0u; mine = 0u;
#pragma unroll
        for (unsigned j = 0; j < 16; ++j) { const unsigned c = xb_ld(&bar[XB_XCNT(j)]); sum += c; cnt += (c > 0u) ? 1u : 0u; mine = (j == x) ? c : mine; }
        if (sum == G) break;
        __builtin_amdgcn_s_sleep(1);
        if ((++sp & 255u) == 0u) { if (xb_ld(&bar[XB_TMO])) break; if (sp > XB_SPIN_CAP) { atomicAdd(&bar[XB_TMO], 1u); break; } }
    }
    nloc = mine > 0u ? mine : 1u; nx = cnt > 0u ? cnt : 1u;
}
__device__ __forceinline__ void xcd_barrier(const XcdBarrier& b) {
    asm volatile("s_waitcnt vmcnt(0)" ::: "memory");
    __syncthreads();
    if (threadIdx.x == 0) {
        unsigned* bar = b.bar;
        unsigned bx = b.x; asm volatile("" : "+s"(bx));
        __builtin_amdgcn_s_waitcnt(0);
        unsigned nloc = b.st[0], nx = b.st[1];
        if (nloc == 0u) { xcd_barrier_complete(bar, bx, nloc, nx); b.st[0] = nloc; b.st[1] = nx; }
        const unsigned old = xb_add(&bar[XB_XSUB(bx)], 1u);
        const unsigned gen = old / nloc;
        if (old + 1u == (gen + 1u) * nloc) {
            __builtin_amdgcn_fence(__ATOMIC_RELEASE, "agent");
            asm volatile("s_waitcnt vmcnt(0)" ::: "memory");
            const unsigned og = xb_add(&bar[XB_TOP], 1u);
            const unsigned tg = og / nx;
            if (og + 1u == (tg + 1u) * nx) xb_add(&bar[XB_TOPGEN], 1u);
            else XB_SPIN(xb_ld(&bar[XB_TOPGEN]) == tg, bar);
            __builtin_amdgcn_fence(__ATOMIC_ACQUIRE, "agent");
            xb_add(&bar[XB_XGEN(bx)], 1u);
            asm volatile("s_waitcnt vmcnt(0)" ::: "memory");
        } else {
            XB_SPIN(xb_ld(&bar[XB_XGEN(bx)]) == gen, bar);
            __builtin_amdgcn_fence(__ATOMIC_ACQUIRE, "agent");
            asm volatile("s_waitcnt vmcnt(0)" ::: "memory");
        }
    }
    __syncthreads();
}

__device__ __forceinline__ int otid() { int t = threadIdx.x & 255; asm volatile("" : "+v"(t)); return t; }
__device__ __forceinline__ int rtid() { int t = threadIdx.x; asm volatile("" : "+v"(t)); return t; }
#define VB ((int)(blockIdx.x * 2 + (rtid() >> 8)))
#define NVB ((int)(gridDim.x * 2))
#define VBX ((int)(gridDim.x == 256 ? (((blockIdx.x & 7) << 6) | ((blockIdx.x >> 3) << 1) | (rtid() >> 8)) : (blockIdx.x * 2 + (rtid() >> 8))))
__device__ __forceinline__ float bf2f(bf16_t v) { return __uint_as_float(((unsigned)v) << 16); }
__device__ __forceinline__ bf16_t f2bf(float f) { unsigned u = __float_as_uint(f); u += 0x7fffu + ((u >> 16) & 1u); return (bf16_t)(u >> 16); }
typedef float f32x2_ __attribute__((ext_vector_type(2)));
typedef __bf16 bf16x2_ __attribute__((ext_vector_type(2)));
__device__ __forceinline__ unsigned pk2(float lo, float hi) { const f32x2_ v = {lo, hi}; const bf16x2_ b = __builtin_convertvector(v, bf16x2_); return __builtin_bit_cast(unsigned, b); }
__device__ __forceinline__ float lo2f(unsigned u) { return __uint_as_float(u << 16); }
__device__ __forceinline__ float hi2f(unsigned u) { return __uint_as_float(u & 0xffff0000u); }
__device__ __forceinline__ float silu_f(float x) { return x * __builtin_amdgcn_rcpf(1.0f + __expf(-x)); }
__device__ __forceinline__ float sigmoid_f(float x) { return __builtin_amdgcn_rcpf(1.0f + __expf(-x)); }
__device__ __forceinline__ float gelu_tanh(float x) { const float u = 0.7978845608028654f * (x + 0.044715f * x * x * x); const float t = 1.0f - 2.0f * __builtin_amdgcn_rcpf(1.0f + __expf(2.0f * u)); return 0.5f * x * (1.0f + t); }
__device__ __forceinline__ float xh32_max(float x) { const auto rr = __builtin_amdgcn_permlane32_swap(__float_as_uint(x), __float_as_uint(x), false, false); return __builtin_fmaxf(__uint_as_float(rr[0]), __uint_as_float(rr[1])); }
__device__ __forceinline__ float xh32_sum(float x) { const auto rr = __builtin_amdgcn_permlane32_swap(__float_as_uint(x), __float_as_uint(x), false, false); return __uint_as_float(rr[0]) + __uint_as_float(rr[1]); }
__device__ __forceinline__ float xh16_max(float x) { const auto rr = __builtin_amdgcn_permlane16_swap(__float_as_uint(x), __float_as_uint(x), false, false); return __builtin_fmaxf(__uint_as_float(rr[0]), __uint_as_float(rr[1])); }
__device__ __forceinline__ float xh16_sum(float x) { const auto rr = __builtin_amdgcn_permlane16_swap(__float_as_uint(x), __float_as_uint(x), false, false); return __uint_as_float(rr[0]) + __uint_as_float(rr[1]); }
template <int CTRL> __device__ __forceinline__ float dpp_f(float v) { return __int_as_float(__builtin_amdgcn_update_dpp(0, __float_as_int(v), CTRL, 0xF, 0xF, false)); }
__device__ __forceinline__ float wave_sum(float v) {
    v += dpp_f<0xB1>(v);
    v += dpp_f<0x4E>(v);
    v += dpp_f<0x141>(v);
    v += dpp_f<0x140>(v);
    v = xh16_sum(v);
    return xh32_sum(v);
}
#define R3_S5SLOC   0ull
#define R3_S5HIN    37748736ull
#define R3_S5G      (R3_S5HIN + 18874368ull)
#define R3_MLAQ     (R3_S5G + 37748736ull)
#define R3_MLAK     (R3_MLAQ + 56623104ull)
#define R3_MLAV     (R3_MLAK + 37748736ull)
#define R3_RETYI    (R3_MLAV + 37748736ull)
#define R3_RETRS    (R3_RETYI + 75497472ull)
#define R3_RETRIN   (R3_RETRS + 75497472ull)
#define R3_NAVT     (R3_RETRIN + 37748736ull)
#define R3_END      (R3_NAVT + 37748736ull)
#define R3_BYTES    453000000ull

constexpr size_t wsal(size_t v) { return (v + 255) & ~(size_t)255; }
constexpr size_t WO_bar = 0;
constexpr size_t WO_mod = wsal(WO_bar + (65536));
constexpr size_t WO_ropeM = wsal(WO_mod + ((size_t)DEPTH * 33 * 6144 * 4));
constexpr size_t WO_ropeR = wsal(WO_ropeM + (2048 * 16 * 2 * 4));
constexpr size_t WO_s5pw = wsal(WO_ropeR + (2048 * 32 * 2 * 4));
constexpr size_t WO_s5bb = wsal(WO_s5pw + ((size_t)DEPTH * 16 * 2 * 33 * 128 * 4));
constexpr size_t WO_s5kt = wsal(WO_s5bb + ((size_t)DEPTH * 16 * 2 * 64 * 32 * 4));
constexpr size_t WO_s5ws = wsal(WO_s5kt + ((size_t)DEPTH * 16 * 2 * 32 * 256 * 4));
constexpr size_t WO_s5wo = wsal(WO_s5ws + ((size_t)DEPTH * 16 * 256 * 512 * 2));
constexpr size_t WO_win_t = wsal(WO_s5wo + ((size_t)DEPTH * 16 * 512 * 768 * 2));
constexpr size_t WO_wout_t = wsal(WO_win_t + ((size_t)DEPTH * WIN_N * 1024 * 2));
constexpr size_t WO_wuq_t = wsal(WO_wout_t + ((size_t)DEPTH * 1024 * 1024 * 2));
constexpr size_t WO_wukv_t = wsal(WO_wuq_t + ((size_t)DEPTH * 384 * 192 * 2));
constexpr size_t WO_wglu_t = wsal(WO_wukv_t + ((size_t)DEPTH * 512 * 128 * 2));
constexpr size_t WO_wr_t = wsal(WO_wglu_t + ((size_t)DEPTH * 256 * 256 * 2));
constexpr size_t WO_w13_t = wsal(WO_wr_t + ((size_t)DEPTH * 128 * 3072 * 2));
constexpr size_t WO_w2_t = wsal(WO_w13_t + ((size_t)32 * 1024 * 1024 * 2));
constexpr size_t WO_xc = wsal(WO_w2_t + ((size_t)32 * 1024 * 512 * 2));
constexpr size_t WO_R1 = wsal(WO_xc + ((size_t)TC * 1024 * 4));
constexpr size_t WO_R2 = wsal(WO_R1 + ((size_t)TT * PLD * 2));
constexpr size_t WO_R3 = wsal(WO_R2 + ((size_t)TT * 1024 * 2));
constexpr size_t WO_route_e = wsal(WO_R3 + (R3_BYTES));
constexpr size_t WO_route_p = wsal(WO_route_e + ((size_t)TT * 2 * 4));
constexpr size_t WO_route_g = wsal(WO_route_p + ((size_t)TT * 2 * 4));
constexpr size_t WO_elist = wsal(WO_route_g + ((size_t)TT * 2 * 4));
constexpr size_t WS_TOTAL = wsal(WO_elist + ((size_t)32 * TT * 4));
struct Params {
    const float *x, *c, *ctx, *c_ctx, *w_mod, *b_mod, *g_mix, *g_ffn, *w_in, *mla_g_cq, *mla_g_ckv, *mla_w_uq, *mla_w_ukv, *na_rpb;
    const float *s5_a_re, *s5_a_im, *s5_log_dt, *s5_b_re, *s5_b_im, *s5_c_re, *s5_c_im, *s5_d, *s5_w_glu, *s5_b_glu, *ret_log_decay, *w_out;
    const float *moe_w_group, *moe_b_group, *moe_w_expert, *moe_b_expert, *moe_w1, *moe_w3, *moe_w2, *g_final;
    float* out;
    char* ws;
    __device__ __forceinline__ unsigned* bar_() const { return (unsigned*)(ws + WO_bar); }
    __device__ __forceinline__ float* mod_() const { return (float*)(ws + WO_mod); }
    __device__ __forceinline__ float* ropeM_() const { return (float*)(ws + WO_ropeM); }
    __device__ __forceinline__ float* ropeR_() const { return (float*)(ws + WO_ropeR); }
    __device__ __forceinline__ float* s5pw_() const { return (float*)(ws + WO_s5pw); }
    __device__ __forceinline__ float* s5bb_() const { return (float*)(ws + WO_s5bb); }
    __device__ __forceinline__ float* s5kt_() const { return (float*)(ws + WO_s5kt); }
    __device__ __forceinline__ bf16_t* s5ws_() const { return (bf16_t*)(ws + WO_s5ws); }
    __device__ __forceinline__ bf16_t* s5wo_() const { return (bf16_t*)(ws + WO_s5wo); }
    __device__ __forceinline__ bf16_t* win_t_() const { return (bf16_t*)(ws + WO_win_t); }
    __device__ __forceinline__ bf16_t* wout_t_() const { return (bf16_t*)(ws + WO_wout_t); }
    __device__ __forceinline__ bf16_t* wuq_t_() const { return (bf16_t*)(ws + WO_wuq_t); }
    __device__ __forceinline__ bf16_t* wukv_t_() const { return (bf16_t*)(ws + WO_wukv_t); }
    __device__ __forceinline__ bf16_t* wglu_t_() const { return (bf16_t*)(ws + WO_wglu_t); }
    __device__ __forceinline__ bf16_t* wr_t_() const { return (bf16_t*)(ws + WO_wr_t); }
    __device__ __forceinline__ bf16_t* w13_t_() const { return (bf16_t*)(ws + WO_w13_t); }
    __device__ __forceinline__ bf16_t* w2_t_() const { return (bf16_t*)(ws + WO_w2_t); }
    __device__ __forceinline__ float* xc_() const { return (float*)(ws + WO_xc); }
    __device__ __forceinline__ bf16_t* R1_() const { return (bf16_t*)(ws + WO_R1); }
    __device__ __forceinline__ bf16_t* R2_() const { return (bf16_t*)out; }
    __device__ __forceinline__ bf16_t* UG_() const { return (bf16_t*)((char*)out + (size_t)TT * 1024 * 2); }
    __device__ __forceinline__ bf16_t* XB_() const { return (bf16_t*)(ws + WO_R2); }
    __device__ __forceinline__ char* R3_() const { return (char*)(ws + WO_R3); }
    __device__ __forceinline__ int* route_e_() const { return (int*)(ws + WO_route_e); }
    __device__ __forceinline__ int* route_p_() const { return (int*)(ws + WO_route_p); }
    __device__ __forceinline__ float* route_g_() const { return (float*)(ws + WO_route_g); }
    __device__ __forceinline__ int* elist_() const { return (int*)(ws + WO_elist); }
    __device__ __forceinline__ int* ecnt_() const { return (int*)(ws + WO_bar + 16384); }
};
#define HID_OFF_ELEMS ((size_t)(TT + 1) * 1024)

#define GEMM_LDS_BYTES (65536 + 512)
template <bool TRANS, bool ROWSS, class AF, class BF>
__device__ __forceinline__ void gemm128(const AF& af, const BF& bf, const int K, f32x4 (&acc)[4][4], char* smem) {
    const int tid = otid(), wid = tid >> 6, lane = tid & 63, wr = wid >> 1, wc = wid & 1, fr = lane & 15, fq = lane >> 4;
    float* SS = (float*)(smem + 65536);
#pragma unroll
    for (int m = 0; m < 4; ++m)
#pragma unroll
        for (int n = 0; n < 4; ++n) acc[m][n] = (f32x4){0.f, 0.f, 0.f, 0.f};
    const int r0 = tid >> 2, c0 = ((tid & 3) ^ ((4 - ((r0 >> 2) & 3)) & 3)) * 8;
    const int rdsw = (fq ^ ((4 - ((fr >> 2) & 3)) & 3)) * 16;
    float ss0 = 0.f, ss1 = 0.f;
    auto stage = [&](int kt, int buf) {
        char* base = smem + buf * 32768 + tid * 16;
#pragma unroll
        for (int sub = 0; sub < 2; ++sub) {
            __builtin_amdgcn_global_load_lds((const unsigned*)af(r0, kt + sub * 32 + c0), (unsigned*)(base + sub * 8192), 16, 0, 0);
            __builtin_amdgcn_global_load_lds((const unsigned*)af(r0 + 64, kt + sub * 32 + c0), (unsigned*)(base + sub * 8192 + 4096), 16, 0, 0);
            __builtin_amdgcn_global_load_lds((const unsigned*)bf(r0, kt + sub * 32 + c0), (unsigned*)(base + 16384 + sub * 8192), 16, 0, 0);
            __builtin_amdgcn_global_load_lds((const unsigned*)bf(r0 + 64, kt + sub * 32 + c0), (unsigned*)(base + 16384 + sub * 8192 + 4096), 16, 0, 0);
        }
    };
    stage(0, 0);
    asm volatile("s_waitcnt vmcnt(0)" ::: "memory");
    __syncthreads();
    for (int kt = 0, it = 0; kt < K; kt += 64, ++it) {
        const int cur = it & 1;
        if (kt + 64 < K) stage(kt + 64, cur ^ 1);
        const char* SA = smem + cur * 32768; const char* SB = SA + 16384;
#pragma unroll
        for (int sub = 0; sub < 2; ++sub) {
            bf16x8 At[4], Bt[4];
#pragma unroll
            for (int m = 0; m < 4; ++m) At[m] = *(const bf16x8*)(SA + sub * 8192 + (wr * 64 + m * 16 + fr) * 64 + rdsw);
#pragma unroll
            for (int n = 0; n < 4; ++n) Bt[n] = *(const bf16x8*)(SB + sub * 8192 + (wc * 64 + n * 16 + fr) * 64 + rdsw);
            if (ROWSS) {
                const bf16x8 v0 = *(const bf16x8*)(SA + sub * 8192 + tid * 16), v1 = *(const bf16x8*)(SA + sub * 8192 + 4096 + tid * 16);
#pragma unroll
                for (int j = 0; j < 8; ++j) { const float a = bf2f((bf16_t)v0[j]), b = bf2f((bf16_t)v1[j]); ss0 += a * a; ss1 += b * b; }
            }
#pragma unroll
            for (int m = 0; m < 4; ++m)
#pragma unroll
                for (int n = 0; n < 4; ++n) {
                    if (TRANS) acc[m][n] = __builtin_amdgcn_mfma_f32_16x16x32_bf16(Bt[n], At[m], acc[m][n], 0, 0, 0);
                    else       acc[m][n] = __builtin_amdgcn_mfma_f32_16x16x32_bf16(At[m], Bt[n], acc[m][n], 0, 0, 0);
                }
        }
        asm volatile("s_waitcnt vmcnt(0)" ::: "memory");
        __syncthreads();
    }
    if (ROWSS) {
        ss0 += dpp_f<0xB1>(ss0); ss0 += dpp_f<0x4E>(ss0);
        ss1 += dpp_f<0xB1>(ss1); ss1 += dpp_f<0x4E>(ss1);
        if ((tid & 3) == 0) { SS[r0] = ss0; SS[r0 + 64] = ss1; }
        __syncthreads();
    }
    (void)wr; (void)wc;
}
#define GEMM_SS(smem) ((const float*)((smem) + 65536))


namespace g8 {
constexpr int BM = 256, BK = 64, HALF = 128, HTB = HALF * BK * 2, NXCD = 8, WGM = 8;
__device__ __forceinline__ int lds_byte(int r, int c) { const int st = (r >> 4) * 2 + (c >> 5), rr = r & 15, cc = c & 31, ob = rr * 64 + cc * 2; return st * 1024 + (ob ^ (((ob >> 9) & 1) << 5)); }
__device__ __forceinline__ void stage_rc(int b, int& R, int& C) { const int st = b / 1024, sb = b % 1024, swz = sb ^ (((sb >> 9) & 1) << 5); R = (st >> 1) * 16 + swz / 64; C = (st & 1) * 32 + (swz % 64) / 2; }
struct Unit { int pm, pn; };
struct StaticOrder {
    int nM, nN, nwg, G, c;
    __device__ void init(int M, int N, int G_, int c_) { nM = M / BM; nN = N / BM; nwg = nM * nN; G = G_; c = c_; }
    __device__ bool next(int i, Unit& u) const {
        const long L = (long)i * G + c; if (L >= nwg) return false;
        int wgid = (int)L; { const int q = nwg / NXCD, r = nwg % NXCD, xcd = wgid % NXCD, off = wgid / NXCD; wgid = (xcd < r ? xcd * (q + 1) : r * (q + 1) + (xcd - r) * q) + off; }
        const int nig = WGM * nN, gid = wgid / nig, fm = gid * WGM, gsz = (nM - fm) < WGM ? (nM - fm) : WGM;
        u.pm = fm + ((wgid % nig) % gsz); u.pn = (wgid % nig) / gsz; return true;
    }
};
template <class Sched, class AOFF, class BOFF, class Epi>
__device__ __forceinline__ void gemm8(LAS unsigned char* lds, const bf16_t* Abase, const bf16_t* Btbase, const int K, const Sched& S, const AOFF& aoff, const BOFF& boffu, const Epi& E, const bool early_aoff = false) {
    int tz = threadIdx.x; asm volatile("" : "+v"(tz));
    const int tid = tz, wid = tid >> 6, lane = tid & 63, wr = wid >> 2, wc = wid & 3, fr = lane & 15, fq = lane >> 4;
    const int nt = K / BK;
    unsigned voffB[2];
    unsigned va00, va01, va10, va11;
    {   int RA[2], CA[2];
#pragma unroll
        for (int i = 0; i < 2; ++i) { stage_rc(tid * 16 + i * 8192, RA[i], CA[i]); voffB[i] = (unsigned)(RA[i] * K + CA[i]) * 2u; }
        Unit u0; if (!S.next(0, u0)) return;
        va00 = aoff(u0, RA[0]) + CA[0] * 2u; va01 = aoff(u0, RA[1]) + CA[1] * 2u; va10 = aoff(u0, 128 + RA[0]) + CA[0] * 2u; va11 = aoff(u0, 128 + RA[1]) + CA[1] * 2u; }
    const size_t kstep = (size_t)(BK * 2);
    const size_t hstep = (size_t)HALF * K * 2;
    const unsigned ldsw = (unsigned)wid * 1024u;
    const int aoffl = lds_byte(wr * 64 + fr, fq * 8), boffl = lds_byte(wc * 32 + fr, fq * 8);
#define G8_SA(b, h) (((b) * 2 + (h)) * HTB)
#define G8_SB(b, h) ((4 + (b) * 2 + (h)) * HTB)
#define G8_STAGE(bufoff, gbase, v0, v1) do { \
        __builtin_amdgcn_global_load_lds((const unsigned*)((const char*)(gbase) + (v0)), (LAS unsigned*)(lds + (bufoff) + ldsw), 16, 0, 0); \
        __builtin_amdgcn_global_load_lds((const unsigned*)((const char*)(gbase) + (v1)), (LAS unsigned*)(lds + (bufoff) + ldsw + 8192), 16, 0, 0); } while (0)
#define G8_LDA(dst, b, h) do { _Pragma("unroll") for (int m = 0; m < 4; ++m) _Pragma("unroll") for (int k = 0; k < 2; ++k) dst[m][k] = *(const LAS bf16x8*)(lds + G8_SA(b, h) + aoffl + m * 2048 + k * 1024); } while (0)
#define G8_LDB(dst, b, h) do { _Pragma("unroll") for (int n = 0; n < 2; ++n) _Pragma("unroll") for (int k = 0; k < 2; ++k) dst[n][k] = *(const LAS bf16x8*)(lds + G8_SB(b, h) + boffl + n * 2048 + k * 1024); } while (0)
#define G8_MMA(ai, bj, At, Bt) do { __builtin_amdgcn_s_setprio(1); _Pragma("unroll") for (int m = 0; m < 4; ++m) _Pragma("unroll") for (int n = 0; n < 2; ++n) _Pragma("unroll") for (int k = 0; k < 2; ++k) \
        acc[ai][bj][m][n] = __builtin_amdgcn_mfma_f32_16x16x32_bf16(Bt[n][k], At[m][k], acc[ai][bj][m][n], 0, 0, 0); __builtin_amdgcn_s_setprio(0); } while (0)
#define G8_WAIT_V(n) asm volatile("s_waitcnt vmcnt(" #n ")" ::: "memory")
#define G8_WAIT_L(n) asm volatile("s_waitcnt lgkmcnt(" #n ")" ::: "memory")
#define G8_BAR __builtin_amdgcn_s_barrier()
#define G8_SCHED __builtin_amdgcn_sched_barrier(0)
    Unit cur, nxt; int ui = 0;
    if (!S.next(0, cur)) return;
    f32x4 acc[2][2][4][2];
#pragma unroll
    for (int a = 0; a < 2; ++a)
#pragma unroll
        for (int b = 0; b < 2; ++b)
#pragma unroll
            for (int m = 0; m < 4; ++m)
#pragma unroll
                for (int n = 0; n < 2; ++n) acc[a][b][m][n] = (f32x4){0.f, 0.f, 0.f, 0.f};
    bf16x8 At[4][2], B0[2][2], B1[2][2];
    const char* cA = (const char*)Abase; const char* cB = (const char*)Btbase + boffu(cur);
    G8_STAGE(G8_SB(0, 0), cB, voffB[0], voffB[1]); G8_STAGE(G8_SA(0, 0), cA, va00, va01); G8_STAGE(G8_SB(0, 1), cB + hstep, voffB[0], voffB[1]); G8_STAGE(G8_SA(0, 1), cA, va10, va11);
    if (wr == 1) G8_BAR;
    G8_WAIT_V(4); G8_BAR;
    G8_STAGE(G8_SB(1, 0), cB + kstep, voffB[0], voffB[1]); G8_STAGE(G8_SA(1, 0), cA + kstep, va00, va01); G8_STAGE(G8_SB(1, 1), cB + hstep + kstep, voffB[0], voffB[1]);
    G8_WAIT_V(6); G8_BAR;
    for (;;) {
        const bool has_next = S.next(ui + 1, nxt);
        const char* nB = has_next ? (const char*)Btbase + boffu(nxt) : cB;
        unsigned na00 = 0u, na01 = 0u, na10 = 0u, na11 = 0u;
        if (early_aoff && has_next) {
            int tq = threadIdx.x; asm volatile("" : "+v"(tq)); int R0, C0, R1, C1; stage_rc(tq * 16, R0, C0); stage_rc(tq * 16 + 8192, R1, C1);
            na00 = aoff(nxt, R0) + C0 * 2u; na01 = aoff(nxt, R1) + C1 * 2u; na10 = aoff(nxt, 128 + R0) + C0 * 2u; na11 = aoff(nxt, 128 + R1) + C1 * 2u; }
        for (int t = 0; t < nt; t += 2) {
            const bool last = (t == nt - 2);
            const char* a1 = cA + (size_t)(t + 1) * kstep;
            const char* a2 = last ? cA : cA + (size_t)(t + 2) * kstep; const char* b2 = last ? nB : cB + (size_t)(t + 2) * kstep;
            const char* a3 = a2 + kstep; const char* b3 = b2 + kstep;
            G8_LDB(B0, 0, 0); G8_SCHED; G8_LDA(At, 0, 0); G8_STAGE(G8_SA(1, 1), a1, va10, va11);
            G8_WAIT_L(8); G8_BAR; G8_WAIT_L(0); G8_MMA(0, 0, At, B0); G8_BAR; G8_SCHED;
            if (last && has_next) {
                if (early_aoff) { va00 = na00; va01 = na01; va10 = na10; va11 = na11; }
                else {
                    int tq = threadIdx.x; asm volatile("" : "+v"(tq)); int R0, C0, R1, C1; stage_rc(tq * 16, R0, C0); stage_rc(tq * 16 + 8192, R1, C1);
                    va00 = aoff(nxt, R0) + C0 * 2u; va01 = aoff(nxt, R1) + C1 * 2u; va10 = aoff(nxt, 128 + R0) + C0 * 2u; va11 = aoff(nxt, 128 + R1) + C1 * 2u; }
            }
            G8_LDB(B1, 0, 1); G8_STAGE(G8_SB(0, 0), b2, voffB[0], voffB[1]);
            G8_BAR; G8_WAIT_L(0); G8_MMA(0, 1, At, B1); G8_BAR;
            G8_LDA(At, 0, 1); G8_STAGE(G8_SA(0, 0), a2, va00, va01);
            G8_BAR; G8_WAIT_L(0); G8_MMA(1, 0, At, B0); G8_BAR; G8_SCHED;
            G8_STAGE(G8_SB(0, 1), b2 + hstep, voffB[0], voffB[1]);
            G8_WAIT_V(6); G8_BAR; G8_MMA(1, 1, At, B1); G8_BAR;
            G8_LDB(B0, 1, 0); G8_SCHED; G8_LDA(At, 1, 0); G8_STAGE(G8_SA(0, 1), a2, va10, va11);
            G8_WAIT_L(8); G8_BAR; G8_WAIT_L(0); G8_MMA(0, 0, At, B0); G8_BAR; G8_SCHED;
            G8_LDB(B1, 1, 1); G8_STAGE(G8_SB(1, 0), b3, voffB[0], voffB[1]);
            G8_BAR; G8_WAIT_L(0); G8_MMA(0, 1, At, B1); G8_BAR;
            G8_LDA(At, 1, 1); G8_STAGE(G8_SA(1, 0), a3, va00, va01);
            G8_BAR; G8_WAIT_L(0); G8_MMA(1, 0, At, B0); G8_BAR; G8_SCHED;
            G8_STAGE(G8_SB(1, 1), b3 + hstep, voffB[0], voffB[1]);
            G8_WAIT_V(6); G8_BAR; G8_MMA(1, 1, At, B1); G8_BAR;
        }
        { int te = threadIdx.x; asm volatile("" : "+v"(te)); const int we = te >> 6, le = te & 63; E(acc, cur, we >> 2, we & 3, le & 15, le >> 4); }
        if (!has_next) break;
#pragma unroll
        for (int a = 0; a < 2; ++a)
#pragma unroll
            for (int b = 0; b < 2; ++b)
#pragma unroll
                for (int m = 0; m < 4; ++m)
#pragma unroll
                    for (int n = 0; n < 2; ++n) acc[a][b][m][n] = (f32x4){0.f, 0.f, 0.f, 0.f};
        cur = nxt; cB = nB; ++ui;
    }
    G8_WAIT_V(0);
    if (wr == 0) G8_BAR;
    G8_BAR;
#undef G8_SA
#undef G8_SB
#undef G8_STAGE
#undef G8_LDA
#undef G8_LDB
#undef G8_MMA
#undef G8_WAIT_V
#undef G8_WAIT_L
#undef G8_BAR
#undef G8_SCHED
}
}

__device__ __forceinline__ int conv_items(int Nout, int Krows) { return ((Nout + 255) / 256) * (Krows / 8); }
template <class MAP>
__device__ __forceinline__ void conv_do(int item, const float* W, int ldw, int Krows, bf16_t* Wt, int Nout, const float* ks, const MAP& map) {
    const int nblk = (Nout + 255) / 256;
    const int kb = item / nblk, nb = item % nblk;
    const int n = nb * 256 + otid();
    if (n >= Nout) return;
    int src; float sc; map(n, src, sc);
    u32x4 o;
    if (src < 0) { o = (u32x4){0u, 0u, 0u, 0u}; }
    else {
        float v[8];
#pragma unroll
        for (int j = 0; j < 8; ++j) v[j] = __builtin_nontemporal_load(W + (size_t)(kb * 8 + j) * ldw + src) * (ks ? sc * ks[kb * 8 + j] : sc);
        o.x = pk2(v[0], v[1]); o.y = pk2(v[2], v[3]); o.z = pk2(v[4], v[5]); o.w = pk2(v[6], v[7]);
    }
    *(u32x4*)(Wt + (size_t)n * Krows + kb * 8) = o;
}

#define CT_STRIDE 272
template <class COLF>
__device__ __forceinline__ void conv_tile(int n0, int k0, int ldw, int Krows, bf16_t* Wt, const float* ks, const COLF& colf, char* smem) {
    const int tid = otid(), nl = tid & 63, kr = tid >> 6;
    const float* cp; float sc; colf(n0 + nl, cp, sc);
    __syncthreads();
    float vv[32];
#pragma unroll
    for (int q = 0; q < 32; ++q) { const int k = k0 + q * 4 + kr; vv[q] = cp ? __builtin_nontemporal_load(cp + (size_t)k * ldw) : 0.f; }
#pragma unroll
    for (int q = 0; q < 32; ++q) {
        const int k = k0 + q * 4 + kr;
        *(bf16_t*)(smem + nl * CT_STRIDE + (q * 4 + kr) * 2) = f2bf(vv[q] * (ks ? sc * ks[k] : sc));
    }
    __syncthreads();
#pragma unroll
    for (int i = 0; i < 4; ++i) {
        const int pid = i * 256 + tid, row = pid >> 4, c = pid & 15;
        *(u32x4*)(Wt + (size_t)(n0 + row) * Krows + k0 + c * 8) = *(const u32x4*)(smem + row * CT_STRIDE + c * 16);
    }
}
__device__ __forceinline__ int ct_items(int Nout, int Krows) { return (Nout / 64) * (Krows / 128); }

struct MapWin { __device__ __forceinline__ void operator()(int n, int& src, float& sc) const {
    sc = 1.0f;
    if (n < 192) src = n;
    else if (n < 224) { const int j = n - 192, pi = j >> 1, s = j & 1; src = 320 + pi + 8 * (pi >= 8) + 8 * s; }
    else if (n < 256) src = -1;
    else if (n < 384) src = 192 + (n - 256);
    else if (n < 640) { src = 352 + (n - 384); sc = 0.125f * 1.4426950408889634f; }
    else if (n < 896) src = 608 + (n - 640);
    else if (n < 1152) src = 864 + (n - 896);
    else if (n < 1408) src = 1120 + (n - 1152);
    else if (n < 1920) { const int rk = n >= 1664; const int j = n - (rk ? 1664 : 1408), h = j >> 6, jj = j & 63, pi = jj >> 1, s = jj & 1;
                         src = (rk ? 1632 : 1376) + h * 64 + pi + 16 * (pi >= 16) + 16 * s; sc = rk ? 0.125f : 1.0f; }
    else if (n < 2176) src = 1888 + (n - 1920);
    else if (n < 2432) src = 2144 + (n - 2176);
    else src = -1;
} };
struct MapIdent { __device__ __forceinline__ void operator()(int n, int& src, float& sc) const { src = n; sc = 1.0f; } };
struct MapWuq { __device__ __forceinline__ void operator()(int n, int& src, float& sc) const {
    const int h = n / 96, j = n % 96; sc = 0.10206207261596577f * 1.4426950408889634f;
    if (j < 64) src = h * 96 + j; else { const int pi = (j - 64) >> 1, s = (j - 64) & 1; src = h * 96 + 64 + pi + 8 * (pi >= 8) + 8 * s; }
} };
struct MapWukv { __device__ __forceinline__ void operator()(int n, int& src, float& sc) const {
    sc = 1.0f; if (n < 256) src = (n >> 6) * 128 + (n & 63); else { const int m = n - 256; src = (m >> 6) * 128 + 64 + (m & 63); }
} };

__device__ __forceinline__ void phase_pa(const Params& p, char* smem) {
    const int tid = otid();
    const int n_win = conv_items(WIN_N, 1024), n_wout = conv_items(1024, 1024), n_wuq = conv_items(384, 192), n_wukv = conv_items(512, 128), n_wglu = conv_items(256, 256);
    const int s0 = DEPTH * n_win, s1 = s0 + DEPTH * n_wout, s2 = s1 + DEPTH * n_wuq, s3 = s2 + DEPTH * n_wukv, s4 = s3 + DEPTH * n_wglu;
    const int s5 = s4 + DEPTH * 96, s6 = s5 + 384, s7 = s6 + DEPTH * 32, s8 = s7 + DEPTH * 128 * 2048 / 8 / 256;
    for (int it = VB; it < s8; it += NVB) {
        if (it >= s7) {
            const int idx = (it - s7) * 256 + tid;
            const int k8 = idx % 256, n = (idx / 256) & 127, l = idx / (256 * 128);
            u32x4 o = (u32x4){0u, 0u, 0u, 0u};
            const int kk = (k8 * 8) & 1023, seg = (k8 * 8) >> 10, nn = n < 36 ? n : n - 36;
            if (n < 36 || (n < 72 && seg == 0)) {
                float v[8];
#pragma unroll
                for (int q = 0; q < 8; ++q) {
                    const float w = nn < 4 ? p.moe_w_group[((size_t)l * 1024 + kk + q) * 4 + nn] : p.moe_w_expert[((size_t)l * 1024 + kk + q) * 32 + (nn - 4)];
                    const float hi = bf2f(f2bf(w)); v[q] = n < 36 ? hi : w - hi;
                }
                o.x = pk2(v[0], v[1]); o.y = pk2(v[2], v[3]); o.z = pk2(v[4], v[5]); o.w = pk2(v[6], v[7]);
            }
            *(u32x4*)(p.wr_t_() + ((size_t)l * 128 + n) * 2048 + k8 * 8) = o;
            continue;
        }
        if (it < s0) { const int l = it / n_win; conv_do(it % n_win, p.w_in + (size_t)l * 1024 * IN_COLS, IN_COLS, 1024, p.win_t_() + (size_t)l * WIN_N * 1024, WIN_N, nullptr, MapWin()); }
        else if (it < s1) { const int j = it - s0, l = j / n_wout; conv_do(j % n_wout, p.w_out + (size_t)l * 1024 * 1024, 1024, 1024, p.wout_t_() + (size_t)l * 1024 * 1024, 1024, nullptr, MapIdent()); }
        else if (it < s2) { const int j = it - s1, l = j / n_wuq; conv_do(j % n_wuq, p.mla_w_uq + (size_t)l * 192 * 384, 384, 192, p.wuq_t_() + (size_t)l * 384 * 192, 384, p.mla_g_cq + l * 192, MapWuq()); }
        else if (it < s3) { const int j = it - s2, l = j / n_wukv; conv_do(j % n_wukv, p.mla_w_ukv + (size_t)l * 128 * 512, 512, 128, p.wukv_t_() + (size_t)l * 512 * 128, 512, p.mla_g_ckv + l * 128, MapWukv()); }
        else if (it < s4) { const int j = it - s3, l = j / n_wglu; conv_do(j % n_wglu, p.s5_w_glu + (size_t)l * 256 * 256, 256, 256, p.wglu_t_() + (size_t)l * 256 * 256, 256, nullptr, MapIdent()); }
        else if (it < s5) {
            const int j = it - s4, l = j / 96, cg = j % 96;
            const int col = cg * 64 + (tid & 63), kq = __builtin_amdgcn_readfirstlane(tid >> 6);
            float acc[33];
#pragma unroll
            for (int r = 0; r < 33; ++r) acc[r] = 0.f;
            const float* W = p.w_mod + (size_t)l * 1024 * 6144 + col;
            const int ln = tid & 63;
#pragma unroll 1
            for (int k0 = kq * 256; k0 < kq * 256 + 256; k0 += 64) {
                float car[33];
#pragma unroll
                for (int r = 0; r < 33; ++r) car[r] = silu_f(r < 32 ? p.c[r * 1024 + k0 + ln] : p.c_ctx[k0 + ln]);
#pragma unroll 2
                for (int j = 0; j < 64; ++j) {
                    const float w = __builtin_nontemporal_load(W + (size_t)(k0 + j) * 6144);
#pragma unroll
                    for (int r = 0; r < 33; ++r) acc[r] += __int_as_float(__builtin_amdgcn_readlane(__float_as_int(car[r]), j)) * w;
                }
            }
            float* red = (float*)smem;
            __syncthreads();
#pragma unroll
            for (int r = 0; r < 33; ++r) red[(kq * 33 + r) * 64 + (tid & 63)] = acc[r];
            __syncthreads();
            if (tid < 64) {
                const float bm = p.b_mod[l * 6144 + col];
#pragma unroll
                for (int r = 0; r < 33; ++r) {
                    const float v = red[(0 * 33 + r) * 64 + tid] + red[(1 * 33 + r) * 64 + tid] + red[(2 * 33 + r) * 64 + tid] + red[(3 * 33 + r) * 64 + tid];
                    p.mod_()[((size_t)l * 33 + r) * 6144 + col] = v + bm;
                }
            }
            __syncthreads();
        }
        else if (it < s6) {
            const int idx = (it - s5) * 256 + tid;
            if (idx < 2048 * 16) {
                const int t = idx >> 4, pi = idx & 15;
                const double inv = pow(10000.0, -(double)(pi & 7) / 8.0);
                const double ang = (double)(pi < 8 ? (t >> 6) : (t & 63)) * inv;
                p.ropeM_()[idx * 2] = (float)cos(ang); p.ropeM_()[idx * 2 + 1] = (float)sin(ang);
            } else {
                const int i2 = idx - 2048 * 16, t = i2 >> 5, pi = i2 & 31;
                const double inv = pow(10000.0, -(double)(pi & 15) / 16.0);
                const double ang = (double)(pi < 16 ? (t >> 6) : (t & 63)) * inv;
                p.ropeR_()[i2 * 2] = (float)cos(ang); p.ropeR_()[i2 * 2 + 1] = (float)sin(ang);
            }
        }
        else {
            const int j = it - s6, l = j >> 5, g = (j >> 1) & 15, dir = j & 1;
            if (tid < 64) {
                const int pp = tid;
                const size_t ai = (((size_t)l * 2 + dir) * 16 + g) * 64 + pp;
                const double are = p.s5_a_re[ai], aim = p.s5_a_im[ai];
                const double dt = exp((double)p.s5_log_dt[(l * 2 + dir) * 16 + g]);
                const double ldr = are * dt, ldi = aim * dt;
                float* PW = p.s5pw_() + ((((size_t)l * 16 + g) * 2 + dir) * 33) * 128;
                for (int n = 0; n <= 32; ++n) { const double mg = exp(ldr * n); PW[n * 128 + pp * 2] = (float)(mg * cos(ldi * n)); PW[n * 128 + pp * 2 + 1] = (float)(mg * sin(ldi * n)); }
                const double mg = exp(ldr), abr = mg * cos(ldi), abi = mg * sin(ldi);
                const double nr = abr - 1.0, ni = abi, den = are * are + aim * aim;
                const double fre = (nr * are + ni * aim) / den, fim = (ni * are - nr * aim) / den;
                float* BB = p.s5bb_() + ((((size_t)l * 16 + g) * 2 + dir) * 64 + pp) * 32;
                for (int ci = 0; ci < 16; ++ci) {
                    const double br = p.s5_b_re[ai * 16 + ci], bi = p.s5_b_im[ai * 16 + ci];
                    BB[ci * 2] = (float)(fre * br - fim * bi); BB[ci * 2 + 1] = (float)(fre * bi + fim * br);
                }
            }
        }
    }
}

__device__ __forceinline__ void phase_pb(const Params& p) {
    const int tid = otid();
    for (int it = VB; it < DEPTH * 16 * 2 * 32; it += NVB) {
        const int j = it & 31, dir = (it >> 5) & 1, g = (it >> 6) & 15, l = it >> 10;
        const int co = tid >> 4, ci = tid & 15;
        const float* PW = p.s5pw_() + ((((size_t)l * 16 + g) * 2 + dir) * 33 + j) * 128;
        const float* BB = p.s5bb_() + (((size_t)l * 16 + g) * 2 + dir) * 64 * 32;
        const size_t cb = ((((size_t)l * 2 + dir) * 16 + g) * 16 + co) * 64;
        float acc = 0.f;
        for (int pp = 0; pp < 64; ++pp) {
            const float cr = p.s5_c_re[cb + pp], cim = p.s5_c_im[cb + pp];
            const float ar = PW[pp * 2], ai = PW[pp * 2 + 1];
            const float br = BB[pp * 32 + ci * 2], bi = BB[pp * 32 + ci * 2 + 1];
            const float mr = cr * ar - cim * ai, mi = cr * ai + cim * ar;
            acc += mr * br - mi * bi;
        }
        p.s5kt_()[(size_t)it * 256 + tid] = acc;
    }
}

__device__ __forceinline__ void phase_pc(const Params& p) {
    const int tid = otid();
    const int nA = DEPTH * 16 * 64, nB = DEPTH * 16 * 192;
    for (int it = VB; it < nA + nB; it += NVB) {
        if (it < nA) {
            const int lg = it >> 6, sub = it & 63;
            const int idx = sub * 256 + tid, n = idx >> 6, k8 = idx & 63;
            const int dir = n >> 7, part = (n >> 6) & 1, pp = n & 63;
            const int s = k8 >> 1, ci0 = (k8 & 1) * 8;
            const int e = dir == 0 ? 31 - s : s;
            const float* PW = p.s5pw_() + (((size_t)lg * 2 + dir) * 33 + e) * 128;
            const float* BB = p.s5bb_() + (((size_t)lg * 2 + dir) * 64 + pp) * 32;
            const float ar = PW[pp * 2], ai = PW[pp * 2 + 1];
            float v[8];
#pragma unroll
            for (int q = 0; q < 8; ++q) { const float br = BB[(ci0 + q) * 2], bi = BB[(ci0 + q) * 2 + 1]; v[q] = part == 0 ? (ar * br - ai * bi) : (ar * bi + ai * br); }
            u32x4 o; o.x = pk2(v[0], v[1]); o.y = pk2(v[2], v[3]); o.z = pk2(v[4], v[5]); o.w = pk2(v[6], v[7]);
            *(u32x4*)(p.s5ws_() + ((size_t)lg * 256 + n) * 512 + k8 * 8) = o;
        } else {
            const int j = it - nA, lg = j / 192, sub = j % 192;
            const int idx = sub * 256 + tid, n = idx / 96, k8 = idx % 96;
            const int t = n >> 4, co = n & 15;
            float v[8];
            if (k8 < 64) {
                const int s = k8 >> 1, ci0 = (k8 & 1) * 8;
                const float* KTf = p.s5kt_() + (((size_t)lg * 2 + 0) * 32) * 256;
                const float* KTb = p.s5kt_() + (((size_t)lg * 2 + 1) * 32) * 256;
#pragma unroll
                for (int q = 0; q < 8; ++q) {
                    float a = 0.f;
                    if (s <= t) a += KTf[(t - s) * 256 + co * 16 + ci0 + q];
                    if (s >= t) a += KTb[(s - t) * 256 + co * 16 + ci0 + q];
                    v[q] = a;
                }
            } else {
                const int q0 = (k8 - 64) * 8, dir = q0 >> 7, part = (q0 >> 6) & 1, p0 = q0 & 63;
                const int l = lg >> 4, g = lg & 15;
                const int e = dir == 0 ? t + 1 : 32 - t;
                const float* PW = p.s5pw_() + (((size_t)lg * 2 + dir) * 33 + e) * 128;
                const size_t cb = ((((size_t)l * 2 + dir) * 16 + g) * 16 + co) * 64;
#pragma unroll
                for (int q = 0; q < 8; ++q) {
                    const int pp = p0 + q;
                    const float cr = p.s5_c_re[cb + pp], cim = p.s5_c_im[cb + pp], ar = PW[pp * 2], ai = PW[pp * 2 + 1];
                    v[q] = part == 0 ? (cr * ar - cim * ai) : -(cr * ai + cim * ar);
                }
            }
            u32x4 o; o.x = pk2(v[0], v[1]); o.y = pk2(v[2], v[3]); o.z = pk2(v[4], v[5]); o.w = pk2(v[6], v[7]);
            *(u32x4*)(p.s5wo_() + ((size_t)lg * 512 + n) * 768 + k8 * 8) = o;
        }
    }
}

__device__ __forceinline__ const float* mod_row(const Params& p, int layer, int tk) { return p.mod_() + ((size_t)layer * 33 + (tk < TL ? (tk >> 11) : 32)) * 6144; }
__device__ __forceinline__ void expert_prefix(const Params& p, int layer, int* pblk) {
    __syncthreads();
    if (otid() == 0) { int a = 0; for (int e = 0; e < 32; ++e) { pblk[e] = a; a += (p.ecnt_()[(layer * 32 + e) * 64] + 255) >> 8; } pblk[32] = a; }
    __syncthreads();
}

struct MoeCv { const float* cp; bf16_t* wt; int ldw, krows; };
__device__ __forceinline__ MoeCv moe_cv_desc(const Params& p, const int layer, const int it) {
    MoeCv d; const int tid = otid(), nl = tid & 63, kr = tid >> 6;
    if (it < 4096) {
        const int e = it >> 7, r = it & 127, nb = r >> 3, kb = r & 7, n = nb * 64 + nl;
        const float* w = (((n >> 4) & 1) ? p.moe_w3 : p.moe_w1) + ((size_t)layer * 32 + e) * 1024 * 512;
        d.ldw = 512; d.krows = 1024;
        d.cp = w + (n >> 5) * 16 + (n & 15) + (size_t)(kb * 128 + kr) * 512;
        d.wt = p.w13_t_() + (size_t)e * 1024 * 1024 + (size_t)(nb * 64) * 1024 + kb * 128;
    } else {
        const int j = it - 4096, e = j >> 6, r = j & 63, nb = r >> 2, kb = r & 3, n = nb * 64 + nl;
        d.ldw = 1024; d.krows = 512;
        d.cp = p.moe_w2 + ((size_t)layer * 32 + e) * 512 * 1024 + n + (size_t)(kb * 128 + kr) * 1024;
        d.wt = p.w2_t_() + (size_t)e * 1024 * 512 + (size_t)(nb * 64) * 512 + kb * 128;
    }
    return d;
}
__device__ __forceinline__ void moe_cv_load(const MoeCv& d, float (&vv)[32]) {
#pragma unroll
    for (int q = 0; q < 32; ++q) vv[q] = __builtin_nontemporal_load(d.cp + (size_t)(q * 4) * d.ldw);
}
__device__ __forceinline__ void moe_cv_store(const MoeCv& d, const float (&vv)[32], char* smem) {
    const int tid = otid(), nl = tid & 63, kr = tid >> 6;
    __syncthreads();
#pragma unroll
    for (int q = 0; q < 32; ++q) *(bf16_t*)(smem + nl * CT_STRIDE + (q * 4 + kr) * 2) = f2bf(vv[q]);
    __syncthreads();
#pragma unroll
    for (int i = 0; i < 4; ++i) {
        const int pid = i * 256 + tid, row = pid >> 4, c = pid & 15;
        *(u32x4*)(d.wt + (size_t)row * d.krows + c * 8) = *(const u32x4*)(smem + row * CT_STRIDE + c * 16);
    }
}
__device__ __forceinline__ void moe_conv_range(const Params& p, const int layer, int j, const int jend, const int step, char* smem) {
    float va[32], vb[32]; MoeCv da, db;
    if (j < jend) { da = moe_cv_desc(p, layer, j); moe_cv_load(da, va); }
#pragma unroll 1
    while (j < jend) {
        int jn = j + step;
        if (jn < jend) { db = moe_cv_desc(p, layer, jn); moe_cv_load(db, vb); }
        moe_cv_store(da, va, smem);
        j = jn; if (j >= jend) break;
        jn = j + step;
        if (jn < jend) { da = moe_cv_desc(p, layer, jn); moe_cv_load(da, va); }
        moe_cv_store(db, vb, smem);
        j = jn;
    }
}

__device__ __forceinline__ void moe_conv_item(const Params& p, const int layer, const int it, char* smem) {
    if (it < 4096) {
        const int j = it, e = j >> 7, r = j & 127, nb = r >> 3, kb = r & 7;
        const float* w1 = p.moe_w1 + ((size_t)layer * 32 + e) * 1024 * 512; const float* w3 = p.moe_w3 + ((size_t)layer * 32 + e) * 1024 * 512;
        conv_tile(nb * 64, kb * 128, 512, 1024, p.w13_t_() + (size_t)e * 1024 * 1024, nullptr,
                  [&](int n, const float*& cp, float& sc) { cp = (((n >> 4) & 1) ? w3 : w1) + (n >> 5) * 16 + (n & 15); sc = 1.0f; }, smem);
    } else {
        const int j = it - 4096, e = j >> 6, r = j & 63, nb = r >> 2, kb = r & 3;
        const float* w2 = p.moe_w2 + ((size_t)layer * 32 + e) * 512 * 1024;
        conv_tile(nb * 64, kb * 128, 1024, 512, p.w2_t_() + (size_t)e * 1024 * 512, nullptr,
                  [&](int n, const float*& cp, float& sc) { cp = w2 + n; sc = 1.0f; }, smem);
    }
}

__device__ __forceinline__ void phase_norm1(const Params& p, const int layer, char* smem) {
    const int tid = otid(), wid = tid >> 6, lane = tid & 63;
    int* pblk = (int*)(smem + 64 * CT_STRIDE);
    if (layer > 0) expert_prefix(p, layer - 1, pblk);
    const bool fin = layer == DEPTH;
    const int ntok = fin ? TL : TT;
    const int n_norm = ntok / 16;
    const int n_c13 = 0, n_c2 = 0;
    bf16_t* H = p.R2_();
    const bf16_t* Y = (const bf16_t*)p.R3_();
    for (int it = VB; it < n_norm + n_c13 + n_c2; it += NVB) {
        if (it < n_norm) {
            const int tk0 = it * 16 + wid * 4;
            const float* mdp = layer > 0 ? mod_row(p, layer - 1, tk0) + 5120 : nullptr;
            const float* md = fin ? nullptr : mod_row(p, layer, tk0);
            f32x4 ga[4], sh[4], gt[4];
#pragma unroll
            for (int i = 0; i < 4; ++i) {
                const int c = i * 256 + lane * 4;
                if (fin) { ga[i] = *(const f32x4*)(p.g_final + c); sh[i] = (f32x4){0.f, 0.f, 0.f, 0.f}; }
                else { const f32x4 g = *(const f32x4*)(p.g_mix + layer * 1024 + c), sc = *(const f32x4*)(md + 1024 + c); sh[i] = *(const f32x4*)(md + c);
                       ga[i][0] = g[0] * (1.0f + sc[0]); ga[i][1] = g[1] * (1.0f + sc[1]); ga[i][2] = g[2] * (1.0f + sc[2]); ga[i][3] = g[3] * (1.0f + sc[3]); }
                gt[i] = layer > 0 ? *(const f32x4*)(mdp + c) : (f32x4){0.f, 0.f, 0.f, 0.f};
            }
            bf16_t* XB = p.XB_();
            auto tail = [&](int tk, const f32x4 (&vq)[4]) {
                float ss = 0.f;
#pragma unroll
                for (int i = 0; i < 4; ++i) ss += vq[i][0] * vq[i][0] + vq[i][1] * vq[i][1] + vq[i][2] * vq[i][2] + vq[i][3] * vq[i][3];
                ss = wave_sum(ss);
                const float rstd = rsqrtf(ss * (1.0f / 1024.0f) + 1e-6f);
#pragma unroll
                for (int i = 0; i < 4; ++i) {
                    const int c = i * 256 + lane * 4;
                    float o[4];
#pragma unroll
                    for (int j = 0; j < 4; ++j) o[j] = vq[i][j] * rstd * ga[i][j] + sh[i][j];
                    if (fin) *(f32x4*)(p.out + (size_t)tk * 1024 + c) = (f32x4){o[0], o[1], o[2], o[3]};
                    else { u32x2 w; w.x = pk2(o[0], o[1]); w.y = pk2(o[2], o[3]); *(u32x2*)(H + (size_t)tk * 1024 + c) = w; }
                }
            };
            int ngrp = 1; asm volatile("" : "+s"(ngrp));
#pragma unroll 1
            for (int grp = 0; grp < ngrp; ++grp)
            if (layer == 0) {
                f32x4 v[4][4];
#pragma unroll
                for (int q = 0; q < 4; ++q) {
                    const int tk = tk0 + q;
                    const float* xin = tk < TL ? p.x + (size_t)tk * 1024 : p.ctx + (size_t)(tk - TL) * 1024;
#pragma unroll
                    for (int i = 0; i < 4; ++i) v[q][i] = __builtin_nontemporal_load((const f32x4*)(xin + i * 256 + lane * 4));
                }
#pragma unroll
                for (int q = 0; q < 4; ++q) tail(tk0 + q, v[q]);
            } else {
                u32x2 xb[4][4], y0[4][4], y1[4][4]; float g0[4], g1[4];
#pragma unroll
                for (int q = 0; q < 4; ++q) {
                    const int tk = tk0 + q;
#pragma unroll
                    for (int i = 0; i < 4; ++i) xb[q][i] = __builtin_nontemporal_load((const u32x2*)(XB + (size_t)tk * 1024 + i * 256 + lane * 4));
                    const int e0 = p.route_e_()[tk * 2], e1 = p.route_e_()[tk * 2 + 1];
                    const size_t s0 = (size_t)pblk[e0] * 256 + p.route_p_()[tk * 2], s1 = (size_t)pblk[e1] * 256 + p.route_p_()[tk * 2 + 1];
                    g0[q] = p.route_g_()[tk * 2]; g1[q] = p.route_g_()[tk * 2 + 1];
#pragma unroll
                    for (int i = 0; i < 4; ++i) { y0[q][i] = __builtin_nontemporal_load((const u32x2*)(Y + s0 * 1024 + i * 256 + lane * 4)); y1[q][i] = __builtin_nontemporal_load((const u32x2*)(Y + s1 * 1024 + i * 256 + lane * 4)); }
                }
#pragma unroll
                for (int q = 0; q < 4; ++q) {
                    const int tk = tk0 + q;
                    f32x4 vq[4];
#pragma unroll
                    for (int i = 0; i < 4; ++i) {
                        vq[i][0] = lo2f(xb[q][i].x) + gt[i][0] * (g0[q] * lo2f(y0[q][i].x) + g1[q] * lo2f(y1[q][i].x));
                        vq[i][1] = hi2f(xb[q][i].x) + gt[i][1] * (g0[q] * hi2f(y0[q][i].x) + g1[q] * hi2f(y1[q][i].x));
                        vq[i][2] = lo2f(xb[q][i].y) + gt[i][2] * (g0[q] * lo2f(y0[q][i].y) + g1[q] * lo2f(y1[q][i].y));
                        vq[i][3] = hi2f(xb[q][i].y) + gt[i][3] * (g0[q] * hi2f(y0[q][i].y) + g1[q] * hi2f(y1[q][i].y));
                        if (!fin) { u32x2 w; w.x = pk2(vq[i][0], vq[i][1]); w.y = pk2(vq[i][2], vq[i][3]); __builtin_nontemporal_store(w, (u32x2*)(XB + (size_t)tk * 1024 + i * 256 + lane * 4)); }
                    }
                    tail(tk, vq);
                }
            }
        } else if (it < n_norm + n_c13) {
            const int j = it - n_norm, e = j >> 7, r = j & 127, nb = r >> 3, kb = r & 7;
            const float* w1 = p.moe_w1 + ((size_t)layer * 32 + e) * 1024 * 512; const float* w3 = p.moe_w3 + ((size_t)layer * 32 + e) * 1024 * 512;
            conv_tile(nb * 64, kb * 128, 512, 1024, p.w13_t_() + (size_t)e * 1024 * 1024, nullptr,
                      [&](int n, const float*& cp, float& sc) { cp = (((n >> 4) & 1) ? w3 : w1) + (n >> 5) * 16 + (n & 15); sc = 1.0f; }, smem);
        } else {
            const int j = it - n_norm - n_c13, e = j >> 6, r = j & 63, nb = r >> 2, kb = r & 3;
            const float* w2 = p.moe_w2 + ((size_t)layer * 32 + e) * 512 * 1024;
            conv_tile(nb * 64, kb * 128, 1024, 512, p.w2_t_() + (size_t)e * 1024 * 512, nullptr,
                      [&](int n, const float*& cp, float& sc) { cp = w2 + n; sc = 1.0f; }, smem);
        }
    }
}

__device__ __forceinline__ void rope4(f32x4& v, const float* tab, int pi0) {
    const float c0 = tab[pi0 * 2], s0 = tab[pi0 * 2 + 1], c1 = tab[pi0 * 2 + 2], s1 = tab[pi0 * 2 + 3];
    const float a = v[0] * c0 - v[1] * s0, b = v[1] * c0 + v[0] * s0, c = v[2] * c1 - v[3] * s1, d = v[3] * c1 + v[2] * s1;
    v[0] = a; v[1] = b; v[2] = c; v[3] = d;
}
#define EPI_LOOP_T(...) _Pragma("unroll") for (int m_ = 0; m_ < 4; ++m_) _Pragma("unroll") for (int n_ = 0; n_ < 4; ++n_) { \
    const int row = wr * 64 + m_ * 16 + fr, col = wc * 64 + n_ * 16 + fq * 4; f32x4 v = acc[m_][n_]; __VA_ARGS__ }
#define GEMM_IDS const int tid = otid(), wid = tid >> 6, lane = tid & 63, wr = wid >> 1, wc = wid & 1, fr = lane & 15, fq = lane >> 4; (void)tid; (void)wid; (void)lane;

__device__ __forceinline__ void rope4_hw(f32x4& v, int t, int pi0, int F) {
    const float pos = (float)(pi0 < F ? (t >> 6) : (t & 63));
    const int f0 = pi0 & (F - 1);
    const float k = -13.287712379549449f / (float)F;
    const float x0 = pos * __builtin_amdgcn_exp2f(k * (float)f0) * 0.15915494309189535f, x1 = pos * __builtin_amdgcn_exp2f(k * (float)(f0 + 1)) * 0.15915494309189535f;
    const float c0 = __builtin_amdgcn_cosf(x0), s0 = __builtin_amdgcn_sinf(x0), c1 = __builtin_amdgcn_cosf(x1), s1 = __builtin_amdgcn_sinf(x1);
    const float a = v[0] * c0 - v[1] * s0, b = v[1] * c0 + v[0] * s0, c = v[2] * c1 - v[3] * s1, d = v[3] * c1 + v[2] * s1;
    v[0] = a; v[1] = b; v[2] = c; v[3] = d;
}
__device__ __forceinline__ void phase_win(const Params& p, const int layer, LAS unsigned char* lds, char* smh) {
    const bf16_t* H = p.R2_(); bf16_t* P = p.R1_(); bf16_t* VT = (bf16_t*)(p.R3_() + R3_NAVT);
    g8::StaticOrder S; S.init(TT, WIN_N, gridDim.x, blockIdx.x);
    g8::gemm8(lds, H, p.win_t_() + (size_t)layer * WIN_N * 1024, 1024, S,
        [&](const g8::Unit& u, int row) { return (unsigned)((u.pm * 256 + row) * 2048); },
        [&](const g8::Unit& u) { return (size_t)u.pn * 256 * 2048; },
        [&](const f32x4 (&acc)[2][2][4][2], const g8::Unit& u, int wr, int wc, int fr, int fq) {
            const bool lat = u.pm < TL / 256;
            const int tk0 = u.pm * 256 + wr * 64 + fr;
#pragma unroll
            for (int bj = 0; bj < 2; ++bj) {
                const int cg = __builtin_amdgcn_readfirstlane(u.pn * 256 + bj * 128 + wc * 32);
                if (cg >= PLD) continue;
                if (cg >= PC_NAV && cg < PC_U) {
#pragma unroll
                    for (int ai = 0; ai < 2; ++ai)
#pragma unroll
                        for (int m = 0; m < 4; ++m) {
                            const int tk = tk0 + ai * 128 + m * 16;
                            const int b = lat ? tk >> 11 : (tk - TL) >> 8, sq = lat ? tk & 2047 : SEQ + ((tk - TL) & 255);
#pragma unroll
                            for (int n = 0; n < 2; ++n) {
                                const f32x4 v = acc[ai][bj][m][n];
                                bf16_t* dst = VT + ((size_t)b * 256 + (cg - PC_NAV) + n * 16 + fq * 4) * SEQA + sq;
                                dst[0] = f2bf(v[0]); dst[SEQA] = f2bf(v[1]); dst[2 * SEQA] = f2bf(v[2]); dst[3 * SEQA] = f2bf(v[3]);
                            }
                        }
                } else if (lat && (cg == PC_KR || (cg >= PC_RQ && cg < PC_RV))) {
                    const bool rm = cg == PC_KR;
#pragma unroll
                    for (int ai = 0; ai < 2; ++ai)
#pragma unroll
                        for (int m = 0; m < 4; ++m) {
                            const int tk = tk0 + ai * 128 + m * 16, t = tk & 2047;
                            char* prow = (char*)(P + (size_t)tk * PLD + cg + fq * 4);
#pragma unroll
                            for (int n = 0; n < 2; ++n) {
                                f32x4 v = acc[ai][bj][m][n];
                                const int col = cg + n * 16 + fq * 4;
                                if (rm) rope4_hw(v, t, (col - PC_KR) >> 1, 8); else rope4_hw(v, t, ((col - PC_RQ) & 63) >> 1, 16);
                                u32x2 w; w.x = pk2(v[0], v[1]); w.y = pk2(v[2], v[3]);
                                *(u32x2*)(prow + n * 32) = w;
                            }
                        }
                } else if (cg >= PC_U && cg < PC_RQ) {
                    bf16_t* UG = p.UG_() + ((size_t)((cg - PC_U) >> 4) * TT) * 16 + fq * 4;
#pragma unroll
                    for (int ai = 0; ai < 2; ++ai)
#pragma unroll
                        for (int m = 0; m < 4; ++m) {
                            const int tk = tk0 + ai * 128 + m * 16;
                            char* prow = (char*)(P + (size_t)tk * PLD + cg + fq * 4);
#pragma unroll
                            for (int n = 0; n < 2; ++n) {
                                const f32x4 v = acc[ai][bj][m][n];
                                u32x2 w; w.x = pk2(v[0], v[1]); w.y = pk2(v[2], v[3]);
                                *(u32x2*)(prow + n * 32) = w;
                                *(u32x2*)(UG + ((size_t)n * TT + tk) * 16) = w;
                            }
                        }
                } else {
#pragma unroll
                    for (int ai = 0; ai < 2; ++ai)
#pragma unroll
                        for (int m = 0; m < 4; ++m) {
                            char* prow = (char*)(P + (size_t)(tk0 + ai * 128 + m * 16) * PLD + cg + fq * 4);
#pragma unroll
                            for (int n = 0; n < 2; ++n) {
                                const f32x4 v = acc[ai][bj][m][n];
                                u32x2 w; w.x = pk2(v[0], v[1]); w.y = pk2(v[2], v[3]);
                                *(u32x2*)(prow + n * 32) = w;
                            }
                        }
                }
            }
        });
    {
        const int nwg = (TT / 256) * (WIN_N / 256), rem = nwg % (int)gridDim.x;
        const int first = rem, nidle = (int)gridDim.x - rem;
        asm volatile("s_waitcnt vmcnt(0) lgkmcnt(0)" ::: "memory");
        if ((int)blockIdx.x >= first) {
            const int vb = ((int)blockIdx.x - first) * 2 + (rtid() >> 8), nvb = nidle * 2;
            moe_conv_range(p, layer, vb, 4096, nvb, smh);
        }
    }
}

#define RT_KS_STRIDE 144
#define RT_KT_STRIDE 272
#define RT_KT_OFF (128 * RT_KS_STRIDE)
#define RT_VT_OFF (RT_KT_OFF + 64 * RT_KT_STRIDE)
#define RT_LDS_BYTES (RT_VT_OFF + 64 * RT_KT_STRIDE)
__device__ __forceinline__ int ret_tok0(int b, int c) { return c < 16 ? b * SEQ + c * 128 : TL + b * CTXL + (c - 16) * 128; }
__device__ __forceinline__ void ret_pass1_item(const Params& p, int layer, int item, char* smem) {
    const int tid = otid(), wid = tid >> 6, lane = tid & 63, r = lane & 31, h2 = lane >> 5;
    const bf16_t* P = p.R1_();
    float* YI = (float*)(p.R3_() + R3_RETYI); float* RS = (float*)(p.R3_() + R3_RETRS);
    char* KS = smem; char* KT = smem + RT_KT_OFF; char* VT = smem + RT_VT_OFF;
    const int h = item & 3, bc = item >> 2, b = bc / 18, c = bc % 18;
    const int tok0 = ret_tok0(b, c);
    const float lgf = p.ret_log_decay[(layer * 2 + 0) * 4 + h] * 1.4426950408889634f, lgb = p.ret_log_decay[(layer * 2 + 1) * 4 + h] * 1.4426950408889634f;
    __syncthreads();
#pragma unroll
    for (int i = 0; i < 4; ++i) {
        const int piece = i * 256 + tid, c8 = piece >> 7, key = piece & 127;
        union { u32x4 v; bf16_t e[8]; } wk, wv;
        wk.v = *(const u32x4*)(P + (size_t)(tok0 + key) * PLD + PC_RK + h * 64 + c8 * 8);
        wv.v = *(const u32x4*)(P + (size_t)(tok0 + key) * PLD + PC_RV + h * 64 + c8 * 8);
        *(u32x4*)(KS + key * RT_KS_STRIDE + c8 * 16) = wk.v;
#pragma unroll
        for (int j = 0; j < 8; ++j) {
            *(bf16_t*)(KT + (c8 * 8 + j) * RT_KT_STRIDE + key * 2) = wk.e[j];
            *(bf16_t*)(VT + (c8 * 8 + j) * RT_KT_STRIDE + key * 2) = wv.e[j];
        }
    }
    __syncthreads();
    const int t = wid * 32 + r;
    const int tkq = tok0 + t;
    bf16x8 qf[4];
#pragma unroll
    for (int ks = 0; ks < 4; ++ks) qf[ks] = *(const bf16x8*)(P + (size_t)tkq * PLD + PC_RQ + h * 64 + 16 * ks + 8 * h2);
    f32x16 o0, o1;
#pragma unroll
    for (int i = 0; i < 16; ++i) { o0[i] = 0.f; o1[i] = 0.f; }
#pragma unroll 1
    for (int kt4 = 0; kt4 < 4; ++kt4) {
        f32x16 sc;
#pragma unroll
        for (int i = 0; i < 16; ++i) sc[i] = 0.f;
#pragma unroll
        for (int ks = 0; ks < 4; ++ks) {
            const bf16x8 a = *(const bf16x8*)(KS + (kt4 * 32 + r) * RT_KS_STRIDE + (16 * ks + 8 * h2) * 2);
            sc = __builtin_amdgcn_mfma_f32_32x32x16_bf16(a, qf[ks], sc, 0, 0, 0);
        }
#pragma unroll
        for (int i = 0; i < 16; ++i) {
            const int sidx = kt4 * 32 + (i & 3) + 8 * (i >> 2) + 4 * h2, n = t - sidx;
            sc[i] *= n >= 0 ? __builtin_amdgcn_exp2f(lgf * (float)n) : __builtin_amdgcn_exp2f(lgb * (float)(-n));
        }
#pragma unroll
        for (int s2 = 0; s2 < 2; ++s2) {
            union { bf16x8 v; unsigned u[4]; } pb, a0, a1;
#pragma unroll
            for (int j = 0; j < 4; ++j) pb.u[j] = pk2(sc[8 * s2 + 2 * j], sc[8 * s2 + 2 * j + 1]);
            const int kb = (kt4 * 32 + 16 * s2 + 4 * h2) * 2;
            const u32x2 x0 = *(const u32x2*)(VT + r * RT_KT_STRIDE + kb), x1 = *(const u32x2*)(VT + r * RT_KT_STRIDE + kb + 16);
            const u32x2 y0 = *(const u32x2*)(VT + (32 + r) * RT_KT_STRIDE + kb), y1 = *(const u32x2*)(VT + (32 + r) * RT_KT_STRIDE + kb + 16);
            a0.u[0] = x0.x; a0.u[1] = x0.y; a0.u[2] = x1.x; a0.u[3] = x1.y;
            a1.u[0] = y0.x; a1.u[1] = y0.y; a1.u[2] = y1.x; a1.u[3] = y1.y;
            o0 = __builtin_amdgcn_mfma_f32_32x32x16_bf16(a0.v, pb.v, o0, 0, 0, 0);
            o1 = __builtin_amdgcn_mfma_f32_32x32x16_bf16(a1.v, pb.v, o1, 0, 0, 0);
        }
    }
#pragma unroll
    for (int g4 = 0; g4 < 4; ++g4) {
        *(f32x4*)(YI + (size_t)tkq * 256 + h * 64 + 8 * g4 + 4 * h2) = (f32x4){o0[4 * g4], o0[4 * g4 + 1], o0[4 * g4 + 2], o0[4 * g4 + 3]};
        *(f32x4*)(YI + (size_t)tkq * 256 + h * 64 + 32 + 8 * g4 + 4 * h2) = (f32x4){o1[4 * g4], o1[4 * g4 + 1], o1[4 * g4 + 2], o1[4 * g4 + 3]};
    }
    const int dir = wid & 1, et = wid >> 1;
    f32x16 st0, st1;
#pragma unroll
    for (int i = 0; i < 16; ++i) { st0[i] = 0.f; st1[i] = 0.f; }
#pragma unroll 1
    for (int ks = 0; ks < 8; ++ks) {
        union { bf16x8 v; unsigned u[4]; } a;
        a.v = *(const bf16x8*)(VT + (et * 32 + r) * RT_KT_STRIDE + (16 * ks + 8 * h2) * 2);
#pragma unroll
        for (int j = 0; j < 4; ++j) {
            const int s0i = 16 * ks + 8 * h2 + 2 * j;
            const float w0 = dir == 0 ? __builtin_amdgcn_exp2f(lgf * (float)(127 - s0i)) : __builtin_amdgcn_exp2f(lgb * (float)s0i);
            const float w1 = dir == 0 ? __builtin_amdgcn_exp2f(lgf * (float)(126 - s0i)) : __builtin_amdgcn_exp2f(lgb * (float)(s0i + 1));
            a.u[j] = pk2(lo2f(a.u[j]) * w0, hi2f(a.u[j]) * w1);
        }
        const bf16x8 b0 = *(const bf16x8*)(KT + r * RT_KT_STRIDE + (16 * ks + 8 * h2) * 2);
        const bf16x8 b1 = *(const bf16x8*)(KT + (32 + r) * RT_KT_STRIDE + (16 * ks + 8 * h2) * 2);
        st0 = __builtin_amdgcn_mfma_f32_32x32x16_bf16(a.v, b0, st0, 0, 0, 0);
        st1 = __builtin_amdgcn_mfma_f32_32x32x16_bf16(a.v, b1, st1, 0, 0, 0);
    }
    float* rs = RS + ((size_t)item * 2 + dir) * 4096;
#pragma unroll
    for (int i = 0; i < 16; ++i) {
        const int e = et * 32 + (i & 3) + 8 * (i >> 2) + 4 * h2;
        rs[e * 64 + r] = st0[i]; rs[e * 64 + 32 + r] = st1[i];
    }
}
__device__ __forceinline__ void ret_carry_item(const Params& p, int layer, int item) {
    const int sub = item & 15, dir = (item >> 4) & 1, h = (item >> 5) & 3, b = item >> 7;
    const int el = sub * 256 + otid();
    const float* RS = (const float*)(p.R3_() + R3_RETRS); bf16_t* RIN = (bf16_t*)(p.R3_() + R3_RETRIN);
    const float g128 = exp2f(p.ret_log_decay[(layer * 2 + dir) * 4 + h] * 1.4426950408889634f * 128.0f);
    float v[18];
#pragma unroll
    for (int i = 0; i < 18; ++i) {
        const int k = dir == 0 ? (i < 2 ? 16 + i : i - 2) : 17 - i;
        v[i] = __builtin_nontemporal_load(RS + ((((size_t)b * 18 + k) * 4 + h) * 2 + dir) * 4096 + el);
    }
    float st = 0.f;
#pragma unroll
    for (int i = 0; i < 18; ++i) {
        const int k = dir == 0 ? (i < 2 ? 16 + i : i - 2) : 17 - i;
        RIN[((((size_t)b * 18 + k) * 4 + h) * 2 + dir) * 4096 + el] = f2bf(st);
        st = st * g128 + v[i];
    }
}
__device__ __forceinline__ void ret_pass2_item(const Params& p, int layer, int item) {
    const int tid = otid(), wid = tid >> 6, lane = tid & 63, r = lane & 31, h2 = lane >> 5;
    const bf16_t* P = p.R1_(); bf16_t* MIX = p.R2_();
    const float* YI = (const float*)(p.R3_() + R3_RETYI); const bf16_t* RIN = (const bf16_t*)(p.R3_() + R3_RETRIN);
    const int h = item & 3, bc = item >> 2, b = bc / 18, c = bc % 18;
    const int t = wid * 32 + r, tkq = ret_tok0(b, c) + t;
    const float lgf = p.ret_log_decay[(layer * 2 + 0) * 4 + h] * 1.4426950408889634f, lgb = p.ret_log_decay[(layer * 2 + 1) * 4 + h] * 1.4426950408889634f;
    bf16x8 qf[4];
#pragma unroll
    for (int ks = 0; ks < 4; ++ks) qf[ks] = *(const bf16x8*)(P + (size_t)tkq * PLD + PC_RQ + h * 64 + 16 * ks + 8 * h2);
    f32x16 y0, y1;
#pragma unroll
    for (int g4 = 0; g4 < 4; ++g4) {
        const f32x4 a = __builtin_nontemporal_load((const f32x4*)(YI + (size_t)tkq * 256 + h * 64 + 8 * g4 + 4 * h2)), bq = __builtin_nontemporal_load((const f32x4*)(YI + (size_t)tkq * 256 + h * 64 + 32 + 8 * g4 + 4 * h2));
#pragma unroll
        for (int q = 0; q < 4; ++q) { y0[4 * g4 + q] = a[q]; y1[4 * g4 + q] = bq[q]; }
    }
#pragma unroll
    for (int dir = 0; dir < 2; ++dir) {
        const bf16_t* R = RIN + ((size_t)item * 2 + dir) * 4096;
        f32x16 x0, x1;
#pragma unroll
        for (int i = 0; i < 16; ++i) { x0[i] = 0.f; x1[i] = 0.f; }
#pragma unroll
        for (int ks = 0; ks < 4; ++ks) {
            const bf16x8 a0 = *(const bf16x8*)(R + r * 64 + 16 * ks + 8 * h2), a1 = *(const bf16x8*)(R + (32 + r) * 64 + 16 * ks + 8 * h2);
            x0 = __builtin_amdgcn_mfma_f32_32x32x16_bf16(a0, qf[ks], x0, 0, 0, 0);
            x1 = __builtin_amdgcn_mfma_f32_32x32x16_bf16(a1, qf[ks], x1, 0, 0, 0);
        }
        const float sc = dir == 0 ? __builtin_amdgcn_exp2f(lgf * (float)(t + 1)) : __builtin_amdgcn_exp2f(lgb * (float)(128 - t));
#pragma unroll
        for (int i = 0; i < 16; ++i) { y0[i] += sc * x0[i]; y1[i] += sc * x1[i]; }
    }
    float sm = 0.f;
#pragma unroll
    for (int i = 0; i < 16; ++i) sm += y0[i] + y1[i];
    sm = xh32_sum(sm);
    const float mu = sm * (1.0f / 64.0f);
    float vr = 0.f;
#pragma unroll
    for (int i = 0; i < 16; ++i) { y0[i] -= mu; y1[i] -= mu; vr += y0[i] * y0[i] + y1[i] * y1[i]; }
    vr = xh32_sum(vr);
    const float rs = rsqrtf(vr * (1.0f / 64.0f) + 1e-6f);
#pragma unroll
    for (int g4 = 0; g4 < 4; ++g4) {
        const int e0 = h * 64 + 8 * g4 + 4 * h2;
        const u32x2 ga = *(const u32x2*)(P + (size_t)tkq * PLD + PC_RG + e0), gb = *(const u32x2*)(P + (size_t)tkq * PLD + PC_RG + 32 + e0);
        u32x2 w0, w1;
        w0.x = pk2(silu_f(lo2f(ga.x)) * y0[4 * g4] * rs, silu_f(hi2f(ga.x)) * y0[4 * g4 + 1] * rs);
        w0.y = pk2(silu_f(lo2f(ga.y)) * y0[4 * g4 + 2] * rs, silu_f(hi2f(ga.y)) * y0[4 * g4 + 3] * rs);
        w1.x = pk2(silu_f(lo2f(gb.x)) * y1[4 * g4] * rs, silu_f(hi2f(gb.x)) * y1[4 * g4 + 1] * rs);
        w1.y = pk2(silu_f(lo2f(gb.y)) * y1[4 * g4 + 2] * rs, silu_f(hi2f(gb.y)) * y1[4 * g4 + 3] * rs);
        *(u32x2*)(MIX + (size_t)tkq * 1024 + 768 + e0) = w0;
        *(u32x2*)(MIX + (size_t)tkq * 1024 + 768 + 32 + e0) = w1;
    }
}

__device__ __forceinline__ int s5_tokbase(int R) {
    const int b = R / S5NCH, ch = R % S5NCH;
    return ch < 64 ? b * SEQ + ch * S5CH : TL + b * CTXL + (ch - 64) * S5CH;
}
__device__ __forceinline__ void phase_up(const Params& p, const int layer, char* smem) {
    GEMM_IDS
    const bf16_t* P = p.R1_();
    bf16_t* Q = (bf16_t*)(p.R3_() + R3_MLAQ); bf16_t* Kn = (bf16_t*)(p.R3_() + R3_MLAK); bf16_t* Vv = (bf16_t*)(p.R3_() + R3_MLAV);
    float* Sloc = (float*)(p.R3_() + R3_S5SLOC);
    const bf16_t* Wq = p.wuq_t_() + (size_t)layer * 384 * 192;
    const bf16_t* Wkv = p.wukv_t_() + (size_t)layer * 512 * 128;
    const int nq = 576 * 3, nk = 576 * 2, nv = 576 * 2, ns5 = 16 * 18 * 2, nret = BATCH * 18 * 4;
    for (int it = VBX; it < nq + nk + nv + ns5 + nret; it += NVB) {
        const int it2 = it < nret ? (nq + nk + nv + ns5) + it : (it - nret < ns5 ? (nq + nk + nv) + (it - nret) : it - nret - ns5);
        f32x4 acc[4][4];
        if (it2 >= nq + nk + nv + ns5) { ret_pass1_item(p, layer, it2 - (nq + nk + nv + ns5), smem); __syncthreads(); }
        else if (it2 < nq) {
            const int mt = it2 / 3, nt = it2 % 3;
            gemm128<true, true>([&](int r, int k) { return P + (size_t)(mt * 128 + r) * PLD + PC_CQ + k; },
                                [&](int r, int k) { return Wq + (size_t)(nt * 128 + r) * 192 + k; }, 192, acc, smem);
            const float* SS = GEMM_SS(smem);
            EPI_LOOP_T({
                const int tk = mt * 128 + row, n = nt * 128 + col;
                const float rstd = rsqrtf(SS[row] * (1.0f / 192.0f) + 1e-6f);
                v *= rstd;
                const int j = n % 96;
                if (tk < TL && j >= 64) rope4(v, p.ropeM_() + (tk & 2047) * 32, (j - 64) >> 1);
                u32x2 w; w.x = pk2(v[0], v[1]); w.y = pk2(v[2], v[3]);
                *(u32x2*)(Q + (size_t)tk * 384 + n) = w;
            })
        } else if (it2 < nq + nk) {
            const int j = it2 - nq, mt = j >> 1, nt = j & 1;
            gemm128<true, true>([&](int r, int k) { return P + (size_t)(mt * 128 + r) * PLD + PC_CKV + k; },
                                [&](int r, int k) { return Wkv + (size_t)(nt * 128 + r) * 128 + k; }, 128, acc, smem);
            const float* SS = GEMM_SS(smem);
            bf16_t* O = Kn;
            EPI_LOOP_T({
                const int tk = mt * 128 + row, n = (nt & 1) * 128 + col;
                const float rstd = rsqrtf(SS[row] * (1.0f / 128.0f) + 1e-6f);
                u32x2 w; w.x = pk2(v[0] * rstd, v[1] * rstd); w.y = pk2(v[2] * rstd, v[3] * rstd);
                *(u32x2*)(O + (size_t)tk * 256 + n) = w;
            })
        } else if (it2 < nq + nk + nv) {
            const int j = it2 - nq - nk, mt = j >> 1, nt = j & 1;
            gemm128<false, true>([&](int r, int k) { return P + (size_t)(mt * 128 + r) * PLD + PC_CKV + k; },
                                 [&](int r, int k) { return Wkv + (size_t)(256 + nt * 128 + r) * 128 + k; }, 128, acc, smem);
            const float* SS = GEMM_SS(smem);
#pragma unroll
            for (int m_ = 0; m_ < 4; ++m_)
#pragma unroll
                for (int n_ = 0; n_ < 4; ++n_) {
                    const int row = wr * 64 + m_ * 16 + fq * 4, col = wc * 64 + n_ * 16 + fr;
                    const int tk = mt * 128 + row, n = nt * 128 + col;
                    const int b = tk < TL ? tk >> 11 : (tk - TL) >> 8, sq = tk < TL ? tk & 2047 : SEQ + ((tk - TL) & 255);
                    const f32x4 v = acc[m_][n_];
                    u32x2 w;
                    w.x = pk2(v[0] * rsqrtf(SS[row] * (1.0f / 128.0f) + 1e-6f), v[1] * rsqrtf(SS[row + 1] * (1.0f / 128.0f) + 1e-6f));
                    w.y = pk2(v[2] * rsqrtf(SS[row + 2] * (1.0f / 128.0f) + 1e-6f), v[3] * rsqrtf(SS[row + 3] * (1.0f / 128.0f) + 1e-6f));
                    *(u32x2*)(Vv + ((size_t)b * 256 + n) * SEQA + sq) = w;
                }
            __syncthreads();
        } else {
            const int j = it2 - nq - nk - nv, g = j / 36, r2 = j % 36, mt = r2 >> 1, nt = r2 & 1;
            const bf16_t* Ws = p.s5ws_() + ((size_t)(layer * 16 + g) * 256) * 512;
            const int tb0 = s5_tokbase(mt * 128 + (tid >> 2)), tb1 = s5_tokbase(mt * 128 + 64 + (tid >> 2));
            const bf16_t* UGg = p.UG_() + (size_t)g * TT * 16;
            gemm128<true, false>([&](int r, int k) { return UGg + (size_t)(r < 64 ? tb0 : tb1) * 16 + k; },
                                 [&](int r, int k) { return Ws + (size_t)(nt * 128 + r) * 512 + k; }, 512, acc, smem);
            EPI_LOOP_T({
                const int R = mt * 128 + row, n = nt * 128 + col;
                *(f32x4*)(Sloc + ((size_t)R * 16 + g) * 256 + n) = v;
            })
        }
    }
}

__device__ __forceinline__ void load_row_bf16_64(const bf16_t* ptr, float (&o)[64]) {
#pragma unroll
    for (int i = 0; i < 8; ++i) { const u32x4 w = *(const u32x4*)(ptr + i * 8);
        o[i * 8 + 0] = lo2f(w.x); o[i * 8 + 1] = hi2f(w.x); o[i * 8 + 2] = lo2f(w.y); o[i * 8 + 3] = hi2f(w.y);
        o[i * 8 + 4] = lo2f(w.z); o[i * 8 + 5] = hi2f(w.z); o[i * 8 + 6] = lo2f(w.w); o[i * 8 + 7] = hi2f(w.w); }
}
__device__ __forceinline__ void load_row_bf16_32(const bf16_t* ptr, float (&o)[32]) {
#pragma unroll
    for (int i = 0; i < 4; ++i) { const u32x4 w = *(const u32x4*)(ptr + i * 8);
        o[i * 8 + 0] = lo2f(w.x); o[i * 8 + 1] = hi2f(w.x); o[i * 8 + 2] = lo2f(w.y); o[i * 8 + 3] = hi2f(w.y);
        o[i * 8 + 4] = lo2f(w.z); o[i * 8 + 5] = hi2f(w.z); o[i * 8 + 6] = lo2f(w.w); o[i * 8 + 7] = hi2f(w.w); }
}
__device__ __forceinline__ void store_row_bf16_64(bf16_t* ptr, const float (&o)[64]) {
#pragma unroll
    for (int i = 0; i < 8; ++i) { u32x4 w; w.x = pk2(o[i * 8], o[i * 8 + 1]); w.y = pk2(o[i * 8 + 2], o[i * 8 + 3]); w.z = pk2(o[i * 8 + 4], o[i * 8 + 5]); w.w = pk2(o[i * 8 + 6], o[i * 8 + 7]);
        *(u32x4*)(ptr + i * 8) = w; }
}

template <int N> __device__ __forceinline__ float dot_row_bf16(const bf16_t* ptr, const float* q, float s) {
#pragma unroll
    for (int i = 0; i < N / 8; ++i) { const u32x4 w = *(const u32x4*)(ptr + i * 8);
        s += q[i * 8 + 0] * lo2f(w.x); s += q[i * 8 + 1] * hi2f(w.x); s += q[i * 8 + 2] * lo2f(w.y); s += q[i * 8 + 3] * hi2f(w.y);
        s += q[i * 8 + 4] * lo2f(w.z); s += q[i * 8 + 5] * hi2f(w.z); s += q[i * 8 + 6] * lo2f(w.w); s += q[i * 8 + 7] * hi2f(w.w); }
    return s;
}
__device__ __forceinline__ void axpy_row_bf16_64(const bf16_t* ptr, float* o, float al, float pe) {
#pragma unroll
    for (int i = 0; i < 8; ++i) { const u32x4 w = *(const u32x4*)(ptr + i * 8);
        o[i * 8 + 0] = o[i * 8 + 0] * al + pe * lo2f(w.x); o[i * 8 + 1] = o[i * 8 + 1] * al + pe * hi2f(w.x);
        o[i * 8 + 2] = o[i * 8 + 2] * al + pe * lo2f(w.y); o[i * 8 + 3] = o[i * 8 + 3] * al + pe * hi2f(w.y);
        o[i * 8 + 4] = o[i * 8 + 4] * al + pe * lo2f(w.z); o[i * 8 + 5] = o[i * 8 + 5] * al + pe * hi2f(w.z);
        o[i * 8 + 6] = o[i * 8 + 6] * al + pe * lo2f(w.w); o[i * 8 + 7] = o[i * 8 + 7] * al + pe * hi2f(w.w); }
}
__device__ __forceinline__ void axpy1_row_bf16_64(const bf16_t* ptr, float* o, float pe) {
#pragma unroll
    for (int i = 0; i < 8; ++i) { const u32x4 w = *(const u32x4*)(ptr + i * 8);
        o[i * 8 + 0] += pe * lo2f(w.x); o[i * 8 + 1] += pe * hi2f(w.x); o[i * 8 + 2] += pe * lo2f(w.y); o[i * 8 + 3] += pe * hi2f(w.y);
        o[i * 8 + 4] += pe * lo2f(w.z); o[i * 8 + 5] += pe * hi2f(w.z); o[i * 8 + 6] += pe * lo2f(w.w); o[i * 8 + 7] += pe * hi2f(w.w); }
}
__device__ __forceinline__ void mla_naive_item(const Params& p, int item, bool ctxq) {
    const int tid = otid();
    const bf16_t* P = p.R1_(); const bf16_t* Q = (const bf16_t*)(p.R3_() + R3_MLAQ); const bf16_t* Kn = (const bf16_t*)(p.R3_() + R3_MLAK); const bf16_t* Vv = (const bf16_t*)(p.R3_() + R3_MLAV);
    bf16_t* MIX = p.R2_();
    int b, h, tk, nkeys;
    if (!ctxq) { b = item >> 5; h = (item >> 3) & 3; tk = b * SEQ + (item & 7) * 256 + tid; nkeys = SEQA; }
    else { b = item >> 2; h = item & 3; tk = TL + b * CTXL + tid; nkeys = CTXL; }
    float qn[64], qr[32], o[64];
    load_row_bf16_64(Q + (size_t)tk * 384 + h * 96, qn);
    load_row_bf16_32(Q + (size_t)tk * 384 + h * 96 + 64, qr);
#pragma unroll
    for (int d = 0; d < 64; ++d) o[d] = 0.f;
    float m = -1e30f, l = 0.f;
    for (int kk = 0; kk < nkeys; ++kk) {
        const int kt = ctxq ? (TL + b * CTXL + kk) : (kk < SEQ ? b * SEQ + kk : TL + b * CTXL + (kk - SEQ));
        float s = dot_row_bf16<64>(Kn + (size_t)kt * 256 + h * 64, qn, 0.f);
        s = dot_row_bf16<32>(P + (size_t)kt * PLD + PC_KR, qr, s);
        const float mn = fmaxf(m, s), al = __expf(m - mn), pe = __expf(s - mn);
        l = l * al + pe; m = mn;
        axpy_row_bf16_64(Vv + (size_t)kt * 256 + h * 64, o, al, pe);
    }
    const float inv = 1.0f / l;
#pragma unroll
    for (int d = 0; d < 64; ++d) o[d] *= inv;
    store_row_bf16_64(MIX + (size_t)tk * 1024 + h * 64, o);
}

#define MLA_KS_STRIDE 208
#define MLA_VS_STRIDE 144
#define MLA_VS_OFF (64 * MLA_KS_STRIDE)
__device__ __forceinline__ void mla_item(const Params& p, int item, bool ctxq, char* smem) {
    const int tid = otid(), wid = tid >> 6, lane = tid & 63, r = lane & 31, h2 = lane >> 5;
    const bf16_t* P = p.R1_(); const bf16_t* Q = (const bf16_t*)(p.R3_() + R3_MLAQ); const bf16_t* Kn = (const bf16_t*)(p.R3_() + R3_MLAK); const bf16_t* VT = (const bf16_t*)(p.R3_() + R3_MLAV);
    bf16_t* MIX = p.R2_();
    char* KS = smem; char* VS = smem + MLA_VS_OFF;
    int b, h, tq0, kt0, nkt;
    if (!ctxq) { b = item >> 5; h = (item >> 3) & 3; tq0 = b * SEQ + (item & 7) * 256 + wid * 64 + r; kt0 = 0; nkt = 36; }
    else { b = item >> 2; h = item & 3; tq0 = TL + b * CTXL + wid * 64 + r; kt0 = 32; nkt = 4; }
    bf16x8 qf[2][6];
#pragma unroll
    for (int qt = 0; qt < 2; ++qt)
#pragma unroll
        for (int s = 0; s < 6; ++s) qf[qt][s] = *(const bf16x8*)(Q + (size_t)(tq0 + qt * 32) * 384 + h * 96 + 16 * s + 8 * h2);
    f32x16 o0[2], o1[2];
#pragma unroll
    for (int qt = 0; qt < 2; ++qt)
#pragma unroll
        for (int i = 0; i < 16; ++i) { o0[qt][i] = 0.f; o1[qt][i] = 0.f; }
    float m[2] = {0.f, 0.f}, l[2] = {0.f, 0.f};
    u32x4 pk[3], pv[2];
    const char* kp[3]; unsigned kstr[3], kdst[3]; const char* vp[2]; unsigned vdst[2];
#pragma unroll
    for (int i = 0; i < 3; ++i) {
        const int piece = tid + 256 * i, key = piece / 12, c = piece % 12;
        kp[i] = c < 8 ? (const char*)(Kn + (size_t)key * 256 + h * 64 + c * 8) : (const char*)(P + (size_t)key * PLD + PC_KR + (c - 8) * 8);
        kstr[i] = c < 8 ? 512u : (unsigned)(PLD * 2);
        kdst[i] = key * MLA_KS_STRIDE + c * 16;
    }
#pragma unroll
    for (int i = 0; i < 2; ++i) {
        const int piece = tid + 256 * i, d = piece >> 3, c = piece & 7;
        vp[i] = (const char*)(VT + ((size_t)b * 256 + h * 64 + d) * SEQA + c * 8);
        vdst[i] = d * MLA_VS_STRIDE + c * 16;
    }
    auto prefetch = [&](int kt) {
        const int seq0 = kt * 64;
        const unsigned tok0 = seq0 < SEQ ? b * SEQ + seq0 : TL + b * CTXL + (seq0 - SEQ);
#pragma unroll
        for (int i = 0; i < 3; ++i) pk[i] = *(const u32x4*)(kp[i] + (size_t)tok0 * kstr[i]);
#pragma unroll
        for (int i = 0; i < 2; ++i) pv[i] = *(const u32x4*)(vp[i] + seq0 * 2);
    };
    prefetch(kt0);
    const f32x16 zero16 = {0.f, 0.f, 0.f, 0.f, 0.f, 0.f, 0.f, 0.f, 0.f, 0.f, 0.f, 0.f, 0.f, 0.f, 0.f, 0.f};
    const char* KA0 = KS + r * MLA_KS_STRIDE + 16 * h2; const char* KA1 = KA0 + 32 * MLA_KS_STRIDE;
    const char* VA0 = VS + r * MLA_VS_STRIDE + 8 * h2; const char* VA1 = VA0 + 32 * MLA_VS_STRIDE;
    float mxrun[2];
    for (int kt = kt0; kt < kt0 + nkt; ++kt) {
        __syncthreads();
#pragma unroll
        for (int i = 0; i < 3; ++i) *(u32x4*)(KS + kdst[i]) = pk[i];
#pragma unroll
        for (int i = 0; i < 2; ++i) *(u32x4*)(VS + vdst[i]) = pv[i];
        __syncthreads();
        if (kt + 1 < kt0 + nkt) prefetch(kt + 1);
        if (kt == kt0) {
#pragma unroll
            for (int qt = 0; qt < 2; ++qt) {
                f32x16 s0 = __builtin_amdgcn_mfma_f32_32x32x16_bf16(*(const bf16x8*)(KA0), qf[qt][0], zero16, 0, 0, 0);
#pragma unroll
                for (int s = 1; s < 6; ++s) s0 = __builtin_amdgcn_mfma_f32_32x32x16_bf16(*(const bf16x8*)(KA0 + 32 * s), qf[qt][s], s0, 0, 0, 0);
                float mx = s0[0];
#pragma unroll
                for (int i = 1; i < 16; ++i) mx = fmaxf(mx, s0[i]);
                m[qt] = xh32_max(mx); mxrun[qt] = m[qt];
            }
        } else {
#pragma unroll
            for (int qt = 0; qt < 2; ++qt) {
                if (__any(mxrun[qt] > m[qt] + 16.0f)) {
                    const float al = __builtin_amdgcn_exp2f(m[qt] - mxrun[qt]);
                    m[qt] = mxrun[qt]; l[qt] *= al;
#pragma unroll
                    for (int i = 0; i < 16; ++i) { o0[qt][i] *= al; o1[qt][i] *= al; }
                }
            }
        }
#pragma unroll
        for (int t = 0; t < 2; ++t) {
            const char* KA = t == 0 ? KA0 : KA1;
            f32x16 sc[2];
#pragma unroll
            for (int qt = 0; qt < 2; ++qt) {
                sc[qt] = __builtin_amdgcn_mfma_f32_32x32x16_bf16(*(const bf16x8*)(KA), qf[qt][0], zero16, 0, 0, 0);
#pragma unroll
                for (int s = 1; s < 6; ++s) sc[qt] = __builtin_amdgcn_mfma_f32_32x32x16_bf16(*(const bf16x8*)(KA + 32 * s), qf[qt][s], sc[qt], 0, 0, 0);
            }
#pragma unroll
            for (int qt = 0; qt < 2; ++qt) {
                float mx = sc[qt][0];
#pragma unroll
                for (int i = 1; i < 16; ++i) mx = fmaxf(mx, sc[qt][i]);
                mxrun[qt] = fmaxf(mxrun[qt], xh32_max(mx));
                float rs = 0.f;
#pragma unroll
                for (int i = 0; i < 16; ++i) { sc[qt][i] = __builtin_amdgcn_exp2f(sc[qt][i] - m[qt]); rs += sc[qt][i]; }
                l[qt] += xh32_sum(rs);
#pragma unroll
                for (int s = 0; s < 2; ++s) {
                    union { bf16x8 v; unsigned u[4]; } a0, a1, pb;
                    const int kb = (32 * t + 16 * s) * 2;
                    const u32x2 x0 = *(const u32x2*)(VA0 + kb), x1 = *(const u32x2*)(VA0 + kb + 16);
                    const u32x2 y0 = *(const u32x2*)(VA1 + kb), y1 = *(const u32x2*)(VA1 + kb + 16);
                    a0.u[0] = x0.x; a0.u[1] = x0.y; a0.u[2] = x1.x; a0.u[3] = x1.y;
                    a1.u[0] = y0.x; a1.u[1] = y0.y; a1.u[2] = y1.x; a1.u[3] = y1.y;
#pragma unroll
                    for (int j = 0; j < 4; ++j) pb.u[j] = pk2(sc[qt][8 * s + 2 * j], sc[qt][8 * s + 2 * j + 1]);
                    o0[qt] = __builtin_amdgcn_mfma_f32_32x32x16_bf16(a0.v, pb.v, o0[qt], 0, 0, 0);
                    o1[qt] = __builtin_amdgcn_mfma_f32_32x32x16_bf16(a1.v, pb.v, o1[qt], 0, 0, 0);
                }
            }
        }
    }
#pragma unroll
    for (int qt = 0; qt < 2; ++qt) {
        const float inv = 1.0f / l[qt];
        const size_t tkq = (size_t)(tq0 + qt * 32);
#pragma unroll
        for (int g4 = 0; g4 < 4; ++g4) {
            u32x2 w0, w1;
            w0.x = pk2(o0[qt][4 * g4] * inv, o0[qt][4 * g4 + 1] * inv); w0.y = pk2(o0[qt][4 * g4 + 2] * inv, o0[qt][4 * g4 + 3] * inv);
            w1.x = pk2(o1[qt][4 * g4] * inv, o1[qt][4 * g4 + 1] * inv); w1.y = pk2(o1[qt][4 * g4 + 2] * inv, o1[qt][4 * g4 + 3] * inv);
            *(u32x2*)(MIX + tkq * 1024 + h * 64 + 8 * g4 + 4 * h2) = w0;
            *(u32x2*)(MIX + tkq * 1024 + h * 64 + 32 + 8 * g4 + 4 * h2) = w1;
        }
    }
}

#define NA_STRIDE 144
#define NA_VS_OFF (64 * NA_STRIDE)
#define NA_RPB_OFF (2 * 64 * NA_STRIDE)
__device__ __forceinline__ void na_item(const Params& p, int layer, int item, bool ctxq, char* smem) {
    const int tid = otid(), wid = tid >> 6, lane = tid & 63, ql = lane & 15, g = lane >> 4;
    const bf16_t* P = p.R1_(); const bf16_t* VT = (const bf16_t*)(p.R3_() + R3_NAVT); bf16_t* MIX = p.R2_();
    char* KS = smem; char* VS = smem + NA_VS_OFF; float* RPB = (float*)(smem + NA_RPB_OFF);
    int b, r = 0, h, tkq;
    if (!ctxq) { h = item & 3; r = (item >> 2) & 31; b = item >> 7; tkq = b * SEQ + r * 64 + wid * 16 + ql; }
    else { h = item & 3; b = item >> 4; tkq = TL + b * CTXL + ((item >> 2) & 3) * 64 + wid * 16 + ql; }
    const int c = wid * 16 + ql;
    const int rs = min(max(r - 4, 0), 24), cs = min(max(c - 8, 0), 48);
    const int bs = wid == 0 ? 0 : (wid == 1 ? 8 : (wid == 2 ? 24 : 32));
    __syncthreads();
    if (!ctxq) {
        const float* rsrc = p.na_rpb + ((size_t)layer * 4 + h) * 465;
        const int i1 = min(tid + 256, 464);
        const float t0 = rsrc[tid], t1 = rsrc[i1];
        RPB[tid] = t0 * 1.4426950408889634f; RPB[i1] = t1 * 1.4426950408889634f;
    }
    bf16x8 qf[2];
#pragma unroll
    for (int s = 0; s < 2; ++s) qf[s] = *(const bf16x8*)(P + (size_t)tkq * PLD + PC_NAQ + h * 64 + 32 * s + 8 * g);
    f32x4 o[4];
#pragma unroll
    for (int dt = 0; dt < 4; ++dt) o[dt] = (f32x4){0.f, 0.f, 0.f, 0.f};
    float m = -1e30f, l = 0.f;
    const int nst = ctxq ? 4 : 12;
    u32x4 pk[2], pv[2];
    const char* kp[2]; const char* vp[2]; unsigned dst[2];
#pragma unroll
    for (int i = 0; i < 2; ++i) {
        const int piece = tid + 256 * i, rr = piece >> 3, c8 = piece & 7;
        kp[i] = (const char*)(P + (size_t)rr * PLD + PC_NAK + h * 64 + c8 * 8);
        vp[i] = (const char*)(VT + ((size_t)b * 256 + h * 64 + rr) * SEQA + c8 * 8);
        dst[i] = rr * NA_STRIDE + c8 * 16;
    }
    auto prefetch = [&](int st) {
        const bool win = !ctxq && st < 8;
        const int cst = ctxq ? st : st - 8;
        const unsigned tok0 = win ? b * SEQ + (rs + st) * 64 : TL + b * CTXL + cst * 64;
        const int seq0 = win ? (rs + st) * 64 : SEQ + cst * 64;
#pragma unroll
        for (int i = 0; i < 2; ++i) { pk[i] = *(const u32x4*)(kp[i] + (size_t)tok0 * (PLD * 2)); pv[i] = *(const u32x4*)(vp[i] + seq0 * 2); }
    };
    int boff[8];
#pragma unroll
    for (int i = 0; i < 4; ++i) {
        const int kc0 = bs + 4 * g + i, kc1 = kc0 + 16;
        boff[i] = (kc0 >= cs && kc0 < cs + 16) ? kc0 - c + 15 : -1;
        boff[4 + i] = (kc1 >= cs && kc1 < cs + 16) ? kc1 - c + 15 : -1;
    }
    prefetch(0);
    const char* KA = KS + ql * NA_STRIDE + 16 * g; const char* VA = VS + ql * NA_STRIDE + 8 * g;
    for (int st = 0; st < nst; ++st) {
        const bool win = !ctxq && st < 8;
        __syncthreads();
#pragma unroll
        for (int i = 0; i < 2; ++i) { *(u32x4*)(KS + dst[i]) = pk[i]; *(u32x4*)(VS + dst[i]) = pv[i]; }
        __syncthreads();
        if (st + 1 < nst) prefetch(st + 1);
        const int ngrp = win ? 1 : 2;
        for (int gi = 0; gi < ngrp; ++gi) {
            const int kb = win ? bs : gi * 32;
            const f32x4 z4 = (f32x4){0.f, 0.f, 0.f, 0.f};
            f32x4 s0 = __builtin_amdgcn_mfma_f32_16x16x32_bf16(*(const bf16x8*)(KA + kb * NA_STRIDE), qf[0], z4, 0, 0, 0);
            f32x4 s1 = __builtin_amdgcn_mfma_f32_16x16x32_bf16(*(const bf16x8*)(KA + (kb + 16) * NA_STRIDE), qf[0], z4, 0, 0, 0);
            s0 = __builtin_amdgcn_mfma_f32_16x16x32_bf16(*(const bf16x8*)(KA + kb * NA_STRIDE + 64), qf[1], s0, 0, 0, 0);
            s1 = __builtin_amdgcn_mfma_f32_16x16x32_bf16(*(const bf16x8*)(KA + (kb + 16) * NA_STRIDE + 64), qf[1], s1, 0, 0, 0);
            if (win) {
                const float* rp = RPB + (rs + st - r + 7) * 31;
                float bv[8];
#pragma unroll
                for (int i = 0; i < 8; ++i) bv[i] = rp[max(boff[i], 0)];
#pragma unroll
                for (int i = 0; i < 4; ++i) {
                    s0[i] = boff[i] >= 0 ? s0[i] + bv[i] : -1e30f;
                    s1[i] = boff[4 + i] >= 0 ? s1[i] + bv[4 + i] : -1e30f;
                }
            }
            float mx = fmaxf(fmaxf(fmaxf(s0[0], s0[1]), fmaxf(s0[2], s0[3])), fmaxf(fmaxf(s1[0], s1[1]), fmaxf(s1[2], s1[3])));
            mx = xh32_max(xh16_max(mx));
            if (__any(mx > m)) {
                const float mn = fmaxf(m, mx), al = __builtin_amdgcn_exp2f(m - mn);
                m = mn; l *= al;
#pragma unroll
                for (int dt = 0; dt < 4; ++dt) o[dt] *= al;
            }
            float rsum = 0.f;
#pragma unroll
            for (int i = 0; i < 4; ++i) { s0[i] = __builtin_amdgcn_exp2f(s0[i] - m); s1[i] = __builtin_amdgcn_exp2f(s1[i] - m); rsum += s0[i] + s1[i]; }
            rsum = xh32_sum(xh16_sum(rsum));
            l += rsum;
            union { bf16x8 v; unsigned u[4]; } pb;
            pb.u[0] = pk2(s0[0], s0[1]); pb.u[1] = pk2(s0[2], s0[3]); pb.u[2] = pk2(s1[0], s1[1]); pb.u[3] = pk2(s1[2], s1[3]);
#pragma unroll
            for (int dt = 0; dt < 4; ++dt) {
                union { bf16x8 v; unsigned u[4]; } a;
                const u32x2 x0 = *(const u32x2*)(VA + dt * 16 * NA_STRIDE + kb * 2), x1 = *(const u32x2*)(VA + dt * 16 * NA_STRIDE + (kb + 16) * 2);
                a.u[0] = x0.x; a.u[1] = x0.y; a.u[2] = x1.x; a.u[3] = x1.y;
                o[dt] = __builtin_amdgcn_mfma_f32_16x16x32_bf16(a.v, pb.v, o[dt], 0, 0, 0);
            }
        }
    }
    const float inv = 1.0f / l;
#pragma unroll
    for (int dt = 0; dt < 4; ++dt) {
        u32x2 w; w.x = pk2(o[dt][0] * inv, o[dt][1] * inv); w.y = pk2(o[dt][2] * inv, o[dt][3] * inv);
        *(u32x2*)(MIX + (size_t)tkq * 1024 + 256 + h * 64 + dt * 16 + 4 * g) = w;
    }
}

__device__ __forceinline__ void na_naive_item(const Params& p, int layer, int item, bool ctxq) {
    const int tid = otid(), h = tid >> 6, c = tid & 63;
    const bf16_t* P = p.R1_(); bf16_t* MIX = p.R2_();
    int b, r = 0, tk;
    if (!ctxq) { b = item >> 5; r = item & 31; tk = b * SEQ + r * 64 + c; }
    else { b = item >> 2; tk = TL + b * CTXL + (item & 3) * 64 + c; }
    float q[64], o[64];
    load_row_bf16_64(P + (size_t)tk * PLD + PC_NAQ + h * 64, q);
#pragma unroll
    for (int d = 0; d < 64; ++d) o[d] = 0.f;
    float m = -1e30f, l = 0.f;
    if (!ctxq) {
        const int rs = min(max(r - 4, 0), 24), cs = min(max(c - 8, 0), 48);
        const float* rpb = p.na_rpb + ((size_t)layer * 4 + h) * 15 * 31;
        for (int i = 0; i < 128; ++i) {
            const int kr = rs + (i >> 4), kc = cs + (i & 15);
            const int kt = b * SEQ + kr * 64 + kc;
            const float s = dot_row_bf16<64>(P + (size_t)kt * PLD + PC_NAK + h * 64, q, rpb[(kr - r + 7) * 31 + (kc - c + 15)]);
            const float mn = fmaxf(m, s), al = __expf(m - mn), pe = __expf(s - mn);
            l = l * al + pe; m = mn;
            axpy_row_bf16_64(P + (size_t)kt * PLD + PC_NAV + h * 64, o, al, pe);
        }
    }
    for (int i = 0; i < CTXL; ++i) {
        const int kt = TL + b * CTXL + i;
        const float s = dot_row_bf16<64>(P + (size_t)kt * PLD + PC_NAK + h * 64, q, 0.f);
        const float mn = fmaxf(m, s), al = __expf(m - mn), pe = __expf(s - mn);
        l = l * al + pe; m = mn;
        axpy_row_bf16_64(P + (size_t)kt * PLD + PC_NAV + h * 64, o, al, pe);
    }
    const float inv = 1.0f / l;
#pragma unroll
    for (int d = 0; d < 64; ++d) o[d] *= inv;
    store_row_bf16_64(MIX + (size_t)tk * 1024 + 256 + h * 64, o);
}

__device__ __forceinline__ void ret_naive_item(const Params& p, int layer, int item) {
    const int tid = otid(), h = tid >> 6, j = tid & 63;
    const bf16_t* P = p.R1_(); bf16_t* MIX = p.R2_();
    const int b = item / 36, grp = item % 36;
    const bool ctxq = grp >= 32;
    const int t = ctxq ? (grp - 32) * 64 + j : grp * 64 + j;
    const int tk = ctxq ? TL + b * CTXL + t : b * SEQ + t;
    const float lgf = p.ret_log_decay[(layer * 2 + 0) * 4 + h] * 1.4426950408889634f, lgb = p.ret_log_decay[(layer * 2 + 1) * 4 + h] * 1.4426950408889634f;
    float q[64], y[64];
    load_row_bf16_64(P + (size_t)tk * PLD + PC_RQ + h * 64, q);
#pragma unroll
    for (int d = 0; d < 64; ++d) y[d] = 0.f;
    if (!ctxq) {
        for (int s = 0; s < SEQ; ++s) {
            const int kt = b * SEQ + s;
            const float dot = dot_row_bf16<64>(P + (size_t)kt * PLD + PC_RK + h * 64, q, 0.f);
            const int n = t - s;
            const float w = dot * (n >= 0 ? exp2f(lgf * (float)n) : exp2f(lgb * (float)(-n)));
            axpy1_row_bf16_64(P + (size_t)kt * PLD + PC_RV + h * 64, y, w);
        }
    }
    for (int mI = 0; mI < CTXL; ++mI) {
        const int kt = TL + b * CTXL + mI;
        const float dot = dot_row_bf16<64>(P + (size_t)kt * PLD + PC_RK + h * 64, q, 0.f);
        float dec;
        if (!ctxq) dec = exp2f(lgf * (float)(t + CTXL - mI)) + exp2f(lgb * (float)(SEQ - t + mI));
        else { const int n = t - mI; dec = n >= 0 ? exp2f(lgf * (float)n) : exp2f(lgb * (float)(-n)); }
        const float w = dot * dec;
        axpy1_row_bf16_64(P + (size_t)kt * PLD + PC_RV + h * 64, y, w);
    }
    float mu = 0.f;
#pragma unroll
    for (int d = 0; d < 64; ++d) mu += y[d];
    mu *= (1.0f / 64.0f);
    float var = 0.f;
#pragma unroll
    for (int d = 0; d < 64; ++d) { y[d] -= mu; var += y[d] * y[d]; }
    const float rs = rsqrtf(var * (1.0f / 64.0f) + 1e-6f);
    float g[64];
    load_row_bf16_64(P + (size_t)tk * PLD + PC_RG + h * 64, g);
#pragma unroll
    for (int d = 0; d < 64; ++d) y[d] = silu_f(g[d]) * y[d] * rs;
    store_row_bf16_64(MIX + (size_t)tk * 1024 + 768 + h * 64, y);
}

__device__ __forceinline__ void s5_carry_item(const Params& p, int layer, int item) {
    const int gt = item * 256 + otid();
    const int pp = gt & 63, dir = (gt >> 6) & 1, g = (gt >> 7) & 15, b = gt >> 11;
    const float* PW = p.s5pw_() + ((((size_t)layer * 16 + g) * 2 + dir) * 33 + 32) * 128;
    const float ar = PW[pp * 2], ai = PW[pp * 2 + 1];
    const float* Sloc = (const float*)(p.R3_() + R3_S5SLOC); bf16_t* Hin = (bf16_t*)(p.R3_() + R3_S5HIN);
    float sr = 0.f, si = 0.f;
#pragma unroll 1
    for (int i0 = 0; i0 < S5NCH; i0 += 12) {
        float xr[12], xi[12];
#pragma unroll
        for (int j = 0; j < 12; ++j) {
            const int i = i0 + j;
            const int k = dir == 0 ? (i < 8 ? 64 + i : i - 8) : 71 - i;
            const size_t row = ((size_t)(b * S5NCH + k) * 16 + g) * 256 + dir * 128;
            xr[j] = __builtin_nontemporal_load(Sloc + row + pp); xi[j] = __builtin_nontemporal_load(Sloc + row + 64 + pp);
        }
#pragma unroll
        for (int j = 0; j < 12; ++j) {
            const int i = i0 + j;
            const int k = dir == 0 ? (i < 8 ? 64 + i : i - 8) : 71 - i;
            const size_t row = ((size_t)(b * S5NCH + k) * 16 + g) * 256 + dir * 128;
            Hin[row + pp] = f2bf(sr); Hin[row + 64 + pp] = f2bf(si);
            const float nr = ar * sr - ai * si + xr[j], ni = ar * si + ai * sr + xi[j];
            sr = nr; si = ni;
        }
    }
}

__device__ __forceinline__ void phase_mix(const Params& p, const int layer, char* smem) {
    const bool need_ctx = layer < DEPTH - 1;
    const int n_mla = 1024, n_mlac = need_ctx ? 128 : 0, n_ret = BATCH * 4 * 2 * 16, n_na = 4096, n_nac = need_ctx ? 512 : 0, n_s5 = 256;
    const int e0 = n_s5, e1 = e0 + n_mlac, e2 = e1 + n_mla, e3 = e2 + n_na, e4 = e3 + n_nac, e5 = e4 + n_ret;
    for (int it = VB; it < e5; it += NVB) {
        if (it < e0) s5_carry_item(p, layer, it);
        else if (it < e1) mla_item(p, it - e0, true, smem);
        else if (it < e2) mla_item(p, it - e1, false, smem);
        else if (it < e3) na_item(p, layer, it - e2, false, smem);
        else if (it < e4) na_item(p, layer, it - e3, true, smem);
        else ret_carry_item(p, layer, it - e4);
    }
}

__device__ __forceinline__ void phase_s5out(const Params& p, const int layer, char* smem) {
    GEMM_IDS
    const bf16_t* P = p.R1_(); const bf16_t* Hin = (const bf16_t*)(p.R3_() + R3_S5HIN); bf16_t* G = (bf16_t*)(p.R3_() + R3_S5G);
    const float* dsk = p.s5_d + layer * 256;
    const int nret2 = BATCH * 18 * 4;
    for (int it = VBX; it < 16 * 18 * 4 + nret2; it += NVB) {
        if (it >= 16 * 18 * 4) { const int j = it - 16 * 18 * 4; if (layer < DEPTH - 1 || ((j >> 2) % 18) < 16) ret_pass2_item(p, layer, j); continue; }
        const int g = it / 72, r2 = it % 72, mt = r2 >> 2, nt = r2 & 3;
        const bf16_t* Wo = p.s5wo_() + ((size_t)(layer * 16 + g) * 512) * 768;
        const int R0 = mt * 128 + (tid >> 2), R1 = R0 + 64;
        const int tb0 = s5_tokbase(R0), tb1 = s5_tokbase(R1);
        const bf16_t* UGg = p.UG_() + (size_t)g * TT * 16;
        f32x4 acc[4][4];
        gemm128<true, false>([&](int r, int k) { const int tb = r < 64 ? tb0 : tb1; const int R = r < 64 ? R0 : R1;
                                 return k < 512 ? UGg + (size_t)tb * 16 + k : Hin + ((size_t)R * 16 + g) * 256 + (k - 512); },
                             [&](int r, int k) { return Wo + (size_t)(nt * 128 + r) * 768 + k; }, 768, acc, smem);
        EPI_LOOP_T({
            const int R = mt * 128 + row, n = nt * 128 + col;
            const int tk = s5_tokbase(R) + (n >> 4), ch = g * 16 + (n & 15);
            const u32x2 uu = *(const u32x2*)(P + (size_t)tk * PLD + PC_U + ch);
            const f32x4 dd = *(const f32x4*)(dsk + ch);
            const float y0 = gelu_tanh(v[0] + dd[0] * lo2f(uu.x)), y1 = gelu_tanh(v[1] + dd[1] * hi2f(uu.x));
            const float y2 = gelu_tanh(v[2] + dd[2] * lo2f(uu.y)), y3 = gelu_tanh(v[3] + dd[3] * hi2f(uu.y));
            u32x2 w; w.x = pk2(y0, y1); w.y = pk2(y2, y3);
            *(u32x2*)(G + (size_t)tk * 256 + ch) = w;
        })
    }
}

__device__ __forceinline__ void phase_glu(const Params& p, const int layer, char* smem) {
    GEMM_IDS
    const bf16_t* G = (const bf16_t*)(p.R3_() + R3_S5G); bf16_t* MIX = p.R2_();
    const bf16_t* Wg = p.wglu_t_() + (size_t)layer * 256 * 256;
    const float* bg = p.s5_b_glu + layer * 256;
    const int nmt = layer < DEPTH - 1 ? 576 : 512;
    for (int it = VBX; it < nmt * 2; it += NVB) {
        const int mt = it >> 1, nt = it & 1;
        f32x4 acc[4][4];
        gemm128<true, false>([&](int r, int k) { return G + (size_t)(mt * 128 + r) * 256 + k; },
                             [&](int r, int k) { return Wg + (size_t)(nt * 128 + r) * 256 + k; }, 256, acc, smem);
        EPI_LOOP_T({
            const int tk = mt * 128 + row, n = nt * 128 + col;
            const u32x2 gg = *(const u32x2*)(G + (size_t)tk * 256 + n);
            const f32x4 bb = *(const f32x4*)(bg + n);
            u32x2 w; w.x = pk2(lo2f(gg.x) * sigmoid_f(v[0] + bb[0]), hi2f(gg.x) * sigmoid_f(v[1] + bb[1]));
            w.y = pk2(lo2f(gg.y) * sigmoid_f(v[2] + bb[2]), hi2f(gg.y) * sigmoid_f(v[3] + bb[3]));
            *(u32x2*)(MIX + (size_t)tk * 1024 + 512 + n) = w;
        })
    }
}

__device__ __forceinline__ void phase_wout(const Params& p, const int layer, LAS unsigned char* lds, char* smh) {
    const bf16_t* MIX = p.R2_();
    g8::StaticOrder S; S.init(layer < DEPTH - 1 ? TT : TL, 1024, gridDim.x, blockIdx.x);
    g8::gemm8(lds, MIX, p.wout_t_() + (size_t)layer * 1024 * 1024, 1024, S,
        [&](const g8::Unit& u, int row) { return (unsigned)((u.pm * 256 + row) * 2048); },
        [&](const g8::Unit& u) { return (size_t)u.pn * 256 * 2048; },
        [&](const f32x4 (&acc)[2][2][4][2], const g8::Unit& u, int wr, int wc, int fr, int fq) {
            bf16_t* WO = (bf16_t*)p.R3_();
#pragma unroll
            for (int ai = 0; ai < 2; ++ai)
#pragma unroll
                for (int m = 0; m < 4; ++m) {
                    const size_t tk = (size_t)u.pm * 256 + ai * 128 + wr * 64 + m * 16 + fr;
#pragma unroll
                    for (int bj = 0; bj < 2; ++bj)
#pragma unroll
                        for (int n = 0; n < 2; ++n) {
                            const f32x4 v = acc[ai][bj][m][n];
                            u32x2 w; w.x = pk2(v[0], v[1]); w.y = pk2(v[2], v[3]);
                            *(u32x2*)(WO + tk * 1024 + u.pn * 256 + bj * 128 + wc * 32 + n * 16 + fq * 4) = w;
                        }
                }
        });
    {
        const int nwg = ((layer < DEPTH - 1 ? TT : TL) / 256) * 4, rem = nwg % (int)gridDim.x;
        const int first = rem, nidle = (int)gridDim.x - rem;
        asm volatile("s_waitcnt vmcnt(0) lgkmcnt(0)" ::: "memory");
        if ((int)blockIdx.x >= first) {
            const int vb = ((int)blockIdx.x - first) * 2 + (rtid() >> 8), nvb = nidle * 2;
            moe_conv_range(p, layer, 4096 + vb, 6144, nvb, smh);
        }
    }
}

#define N2_LG_OFF 0
__device__ __forceinline__ void phase_norm2(const Params& p, const int layer, char* smem) {
    GEMM_IDS
    bf16_t* F = p.R1_();
    const int nmain = TL / 128, ntile = nmain + (layer < DEPTH - 1 ? TC / 16 : 0);
    const bf16_t* Wr = p.wr_t_() + (size_t)layer * 128 * 2048;
    float* LG = (float*)(smem + N2_LG_OFF);
    if (VB == 0) { unsigned z = 0u; asm volatile("" : "+v"(z)); u32x2 zz; zz.x = z; zz.y = z; *(u32x2*)(F + (size_t)TT * 1024 + tid * 4) = zz; }
    for (int it = VB; it < ntile; it += NVB) {
        const bool mini = it >= nmain;
        const int tok0 = mini ? TL + (it - nmain) * 16 : it * 128, nrows = mini ? 16 : 128, rpw = nrows >> 2;
        {
            const float* md = mod_row(p, layer, tok0);
            f32x4 ga[4], sh[4], gt[4];
#pragma unroll
            for (int i = 0; i < 4; ++i) {
                const int c = i * 256 + lane * 4;
                const f32x4 g = *(const f32x4*)(p.g_ffn + layer * 1024 + c), sc = *(const f32x4*)(md + 4096 + c);
                sh[i] = *(const f32x4*)(md + 3072 + c); gt[i] = *(const f32x4*)(md + 2048 + c);
                ga[i][0] = g[0] * (1.0f + sc[0]); ga[i][1] = g[1] * (1.0f + sc[1]); ga[i][2] = g[2] * (1.0f + sc[2]); ga[i][3] = g[3] * (1.0f + sc[3]);
            }
            bf16_t* XB = p.XB_();
            const bf16_t* WOb = (const bf16_t*)p.R3_();
            auto tail = [&](int tk, f32x4 (&vq)[4], const u32x2 (&woq)[4]) {
                float ss = 0.f;
#pragma unroll
                for (int i = 0; i < 4; ++i) {
                    vq[i][0] += gt[i][0] * lo2f(woq[i].x); vq[i][1] += gt[i][1] * hi2f(woq[i].x); vq[i][2] += gt[i][2] * lo2f(woq[i].y); vq[i][3] += gt[i][3] * hi2f(woq[i].y);
                    u32x2 xw; xw.x = pk2(vq[i][0], vq[i][1]); xw.y = pk2(vq[i][2], vq[i][3]);
                    __builtin_nontemporal_store(xw, (u32x2*)(XB + (size_t)tk * 1024 + i * 256 + lane * 4));
                    ss += vq[i][0] * vq[i][0] + vq[i][1] * vq[i][1] + vq[i][2] * vq[i][2] + vq[i][3] * vq[i][3];
                }
                ss = wave_sum(ss);
                const float rstd = rsqrtf(ss * (1.0f / 1024.0f) + 1e-6f);
#pragma unroll
                for (int i = 0; i < 4; ++i) {
                    const int c = i * 256 + lane * 4;
                    float f[4];
#pragma unroll
                    for (int j = 0; j < 4; ++j) f[j] = vq[i][j] * rstd * ga[i][j] + sh[i][j];
                    u32x2 w; w.x = pk2(f[0], f[1]); w.y = pk2(f[2], f[3]);
                    *(u32x2*)(F + (size_t)tk * 1024 + c) = w;
                }
            };
#pragma unroll 1
            for (int rr = 0; rr < rpw; rr += 4) {
                const int tkb = tok0 + wid * rpw + rr;
                if (layer == 0) {
                    f32x4 v[4][4]; u32x2 wo[4][4];
#pragma unroll
                    for (int q = 0; q < 4; ++q) {
                        const int tk = tkb + q;
                        const float* xin = tk < TL ? p.x + (size_t)tk * 1024 : p.ctx + (size_t)(tk - TL) * 1024;
#pragma unroll
                        for (int i = 0; i < 4; ++i) { v[q][i] = __builtin_nontemporal_load((const f32x4*)(xin + i * 256 + lane * 4)); wo[q][i] = __builtin_nontemporal_load((const u32x2*)(WOb + (size_t)tk * 1024 + i * 256 + lane * 4)); }
                    }
#pragma unroll
                    for (int q = 0; q < 4; ++q) tail(tkb + q, v[q], wo[q]);
                } else {
                    u32x2 xb[4][4], wo[4][4];
#pragma unroll
                    for (int q = 0; q < 4; ++q) {
                        const int tk = tkb + q;
#pragma unroll
                        for (int i = 0; i < 4; ++i) { xb[q][i] = __builtin_nontemporal_load((const u32x2*)(XB + (size_t)tk * 1024 + i * 256 + lane * 4)); wo[q][i] = __builtin_nontemporal_load((const u32x2*)(WOb + (size_t)tk * 1024 + i * 256 + lane * 4)); }
                    }
#pragma unroll
                    for (int q = 0; q < 4; ++q) {
                        f32x4 vq[4];
#pragma unroll
                        for (int i = 0; i < 4; ++i) vq[i] = (f32x4){lo2f(xb[q][i].x), hi2f(xb[q][i].x), lo2f(xb[q][i].y), hi2f(xb[q][i].y)};
                        tail(tkb + q, vq, wo[q]);
                    }
                }
            }
        }
        asm volatile("s_waitcnt vmcnt(0)" ::: "memory");
        __syncthreads();
        f32x4 acc[4][4];
        gemm128<true, false>([&](int r, int k) { return F + (size_t)(tok0 + (r < nrows ? r : 0)) * 1024 + k; },
                             [&](int r, int k) { return Wr + (size_t)r * 2048 + k; }, 1024, acc, smem);
#pragma unroll
        for (int m_ = 0; m_ < 4; ++m_)
#pragma unroll
            for (int n_ = 0; n_ < 4; ++n_) {
                const int row = wr * 64 + m_ * 16 + fr, col = wc * 64 + n_ * 16 + fq * 4;
                if (col < 72) *(f32x4*)(LG + row * 72 + col) = acc[m_][n_];
            }
        __syncthreads();
        int re0 = 0, re1 = 0; float rg0 = 0.f, rg1 = 0.f;
        if (tid < nrows) {
            float* lg = LG + tid * 72;
#pragma unroll
            for (int q = 0; q < 36; ++q) lg[q] += lg[36 + q];
            float gl[4]; int gi = 0; float gm = -3.0e38f;
#pragma unroll
            for (int q = 0; q < 4; ++q) { gl[q] = lg[q] + p.moe_b_group[layer * 4 + q]; if (gl[q] > gm) { gm = gl[q]; gi = q; } }
            float gs = 0.f;
#pragma unroll
            for (int q = 0; q < 4; ++q) gs += __expf(gl[q] - gm);
            const float ggate = 1.0f / gs;
            float el[8]; float em = -3.0e38f;
#pragma unroll
            for (int q = 0; q < 8; ++q) { el[q] = lg[4 + gi * 8 + q] + p.moe_b_expert[layer * 32 + gi * 8 + q]; em = fmaxf(em, el[q]); }
            int i0 = 0; float b0 = -3.0e38f;
#pragma unroll
            for (int q = 0; q < 8; ++q) if (el[q] > b0) { b0 = el[q]; i0 = q; }
            int i1 = 0; float b1 = -3.0e38f;
#pragma unroll
            for (int q = 0; q < 8; ++q) if (q != i0 && el[q] > b1) { b1 = el[q]; i1 = q; }
            const float p0 = __expf(b0 - em), p1 = __expf(b1 - em);
            const float g0 = ggate * p0 / (p0 + p1), g1 = ggate * p1 / (p0 + p1);
            const int e0 = gi * 8 + i0, e1 = gi * 8 + i1;
            re0 = e0; re1 = e1; rg0 = g0; rg1 = g1;
        }
        int* lc = (int*)(LG + 128 * 72); int* lbase = lc + 32;
        if (tid < 32) lc[tid] = 0;
        __syncthreads();
        int r0 = 0, r1 = 0;
        if (tid < nrows) { r0 = atomicAdd(lc + re0, 1); r1 = atomicAdd(lc + re1, 1); }
        __syncthreads();
        if (tid < 32) { const int c = lc[tid]; lbase[tid] = c > 0 ? atomicAdd(p.ecnt_() + (layer * 32 + tid) * 64, c) : 0; }
        __syncthreads();
        if (tid < nrows) {
            const int tk = tok0 + tid;
            const int q0 = lbase[re0] + r0, q1 = lbase[re1] + r1;
            p.elist_()[(size_t)re0 * TT + q0] = tk; p.elist_()[(size_t)re1 * TT + q1] = tk;
            p.route_e_()[tk * 2] = re0; p.route_e_()[tk * 2 + 1] = re1; p.route_p_()[tk * 2] = q0; p.route_p_()[tk * 2 + 1] = q1;
            p.route_g_()[tk * 2] = rg0; p.route_g_()[tk * 2 + 1] = rg1;
        }
        __syncthreads();
    }
}

struct MoeOrder {
    int G, c, nunits;
    __device__ bool next(int i, g8::Unit& u) const { const int L = i * G + c; if (L >= nunits) return false; u.pm = L >> 2; u.pn = L & 3; return true; }
};
struct ExpTab {
    int pk, total;
    __device__ __forceinline__ void init(const Params& p, int layer) {
        int tq = threadIdx.x; asm volatile("" : "+v"(tq)); const int ln = tq & 63;
        const int cntv = ln < 32 ? p.ecnt_()[(layer * 32 + ln) * 64] : 0;
        const int nb = (cntv + 255) >> 8;
        int inc = nb;
#pragma unroll
        for (int o = 1; o < 32; o <<= 1) { const int t = __builtin_amdgcn_ds_bpermute(((ln - o) & 63) << 2, inc); if (ln >= o) inc += t; }
        pk = cntv | ((inc - nb) << 20);
        total = __builtin_amdgcn_readlane(inc, 31);
    }
    __device__ __forceinline__ int expert(int rb) const {
        int tq = threadIdx.x; asm volatile("" : "+v"(tq)); const int ln = tq & 63;
        return __popcll(__ballot(ln >= 1 && ln < 32 && (pk >> 20) <= rb));
    }
    __device__ __forceinline__ int first_block(int e) const { return __builtin_amdgcn_readlane(pk, e) >> 20; }
    __device__ __forceinline__ int count(int e) const { return __builtin_amdgcn_readlane(pk, e) & 0xfffff; }
};
__device__ __forceinline__ void phase_moe1(const Params& p, const int layer, LAS unsigned char* lds) {
    ExpTab T; T.init(p, layer);
    const bf16_t* F = p.R1_(); bf16_t* HID = p.R1_() + HID_OFF_ELEMS;
    g8::StaticOrder S; S.init(T.total * 256, 1024, gridDim.x, blockIdx.x);
    g8::gemm8(lds, F, p.w13_t_(), 1024, S,
        [&](const g8::Unit& u, int row) { const int e = T.expert(u.pm), idx = (u.pm - T.first_block(e)) * 256 + row;
                                          const int tok = idx < T.count(e) ? p.elist_()[(size_t)e * TT + idx] : TT; return (unsigned)tok * 2048u; },
        [&](const g8::Unit& u) { return ((size_t)T.expert(u.pm) * 1024 + u.pn * 256) * 2048; },
        [&](const f32x4 (&acc)[2][2][4][2], const g8::Unit& u, int wr, int wc, int fr, int fq) {
#pragma unroll
            for (int ai = 0; ai < 2; ++ai)
#pragma unroll
                for (int m = 0; m < 4; ++m) {
                    const size_t slot = (size_t)u.pm * 256 + ai * 128 + wr * 64 + m * 16 + fr;
#pragma unroll
                    for (int bj = 0; bj < 2; ++bj) {
                        const f32x4 a = acc[ai][bj][m][0], b = acc[ai][bj][m][1];
                        const int j = (u.pn * 8 + bj * 4 + wc) * 16 + fq * 4;
                        u32x2 w; w.x = pk2(silu_f(a[0]) * b[0], silu_f(a[1]) * b[1]); w.y = pk2(silu_f(a[2]) * b[2], silu_f(a[3]) * b[3]);
                        *(u32x2*)(HID + slot * 512 + j) = w;
                    }
                    asm volatile("" ::: "memory");
                }
        }, true);
}
__device__ __forceinline__ void phase_moe2(const Params& p, const int layer, LAS unsigned char* lds) {
    ExpTab T; T.init(p, layer);
    const bf16_t* HID = p.R1_() + HID_OFF_ELEMS; bf16_t* Y = (bf16_t*)p.R3_();
    g8::StaticOrder S; S.init(T.total * 256, 1024, gridDim.x, blockIdx.x);
    g8::gemm8(lds, HID, p.w2_t_(), 512, S,
        [&](const g8::Unit& u, int row) { return (unsigned)((u.pm * 256 + row) * 1024); },
        [&](const g8::Unit& u) { return ((size_t)T.expert(u.pm) * 1024 + u.pn * 256) * 1024; },
        [&](const f32x4 (&acc)[2][2][4][2], const g8::Unit& u, int wr, int wc, int fr, int fq) {
#pragma unroll
            for (int ai = 0; ai < 2; ++ai)
#pragma unroll
                for (int m = 0; m < 4; ++m) {
                    const size_t slot = (size_t)u.pm * 256 + ai * 128 + wr * 64 + m * 16 + fr;
#pragma unroll
                    for (int bj = 0; bj < 2; ++bj)
#pragma unroll
                        for (int n = 0; n < 2; ++n) {
                            const f32x4 v = acc[ai][bj][m][n];
                            u32x2 w; w.x = pk2(v[0], v[1]); w.y = pk2(v[2], v[3]);
                            *(u32x2*)(Y + slot * 1024 + u.pn * 256 + bj * 128 + wc * 32 + n * 16 + fq * 4) = w;
                        }
                    asm volatile("" ::: "memory");
                }
        });
}

#define HALF_LDS 66560
#define DYN_LDS (131072 + 512 + 18432 + 256)
__global__ void __launch_bounds__(512, 2) fwd_kernel(const Params p) {
    extern __shared__ __attribute__((aligned(16))) char smem_all[];
#define smem (smem_all + (rtid() >> 8) * HALF_LDS)
    volatile LAS unsigned* xbw = (volatile LAS unsigned*)(smem_all + DYN_LDS - 16);
    if (threadIdx.x == 0) { xbw[0] = 0u; xbw[1] = 0u; xbw[2] = 0u; xbw[3] = 0u; }
    __syncthreads();
    XcdBarrier bar = xcd_barrier_post(p.bar_(), xbw);
#ifndef ONLY
#define ONLY -1
#endif
#define RUN(id, call) if (ONLY < 0 || ONLY == id) { call; xcd_barrier(bar); }
    RUN(0, phase_pa(p, smem))
    RUN(1, phase_pb(p))
    RUN(2, phase_pc(p))
    for (int layer = 0; layer < DEPTH; ++layer) {
        RUN(3, phase_norm1(p, layer, smem))
        RUN(4, phase_win(p, layer, (LAS unsigned char*)smem_all, smem))
        RUN(5, phase_up(p, layer, smem))
        RUN(6, phase_mix(p, layer, smem))
        RUN(7, phase_s5out(p, layer, smem))
        RUN(8, phase_glu(p, layer, smem))
        RUN(9, phase_wout(p, layer, (LAS unsigned char*)smem_all, smem))
        RUN(10, phase_norm2(p, layer, smem))
        RUN(11, phase_moe1(p, layer, (LAS unsigned char*)smem_all))
        RUN(12, phase_moe2(p, layer, (LAS unsigned char*)smem_all))
    }
    phase_norm1(p, DEPTH, smem);
}

static inline size_t al256(size_t v) { return (v + 255) & ~(size_t)255; }
extern "C" void kernel_launch(void* const* d_in, const int* in_sizes, int n_in, void* d_out, int out_size, void* d_ws, size_t ws_size, hipStream_t stream) {
    (void)in_sizes; (void)n_in; (void)out_size;
    Params p{};
    const float* const* in = (const float* const*)d_in;
    p.x = in[0]; p.c = in[1]; p.ctx = in[2]; p.c_ctx = in[3]; p.w_mod = in[4]; p.b_mod = in[5]; p.g_mix = in[6]; p.g_ffn = in[7]; p.w_in = in[8];
    p.mla_g_cq = in[9]; p.mla_g_ckv = in[10]; p.mla_w_uq = in[11]; p.mla_w_ukv = in[12]; p.na_rpb = in[13];
    p.s5_a_re = in[14]; p.s5_a_im = in[15]; p.s5_log_dt = in[16]; p.s5_b_re = in[17]; p.s5_b_im = in[18]; p.s5_c_re = in[19]; p.s5_c_im = in[20];
    p.s5_d = in[21]; p.s5_w_glu = in[22]; p.s5_b_glu = in[23]; p.ret_log_decay = in[24]; p.w_out = in[25];
    p.moe_w_group = in[26]; p.moe_b_group = in[27]; p.moe_w_expert = in[28]; p.moe_b_expert = in[29]; p.moe_w1 = in[30]; p.moe_w3 = in[31]; p.moe_w2 = in[32]; p.g_final = in[33];
    p.out = (float*)d_out;
    p.ws = (char*)d_ws;
    char* ctrl = p.ws;
    const size_t off = WS_TOTAL;
    if (off > ws_size) return;
    static int grid = 0;
    if (!grid) {
        int dev = 0, cus = 0, per_cu = 0;
        hipGetDevice(&dev);
        hipDeviceGetAttribute(&cus, hipDeviceAttributeMultiprocessorCount, dev);
        hipFuncSetAttribute((const void*)fwd_kernel, hipFuncAttributeMaxDynamicSharedMemorySize, DYN_LDS);
        hipOccupancyMaxActiveBlocksPerMultiprocessor(&per_cu, fwd_kernel, 512, DYN_LDS);
        if (per_cu < 1) per_cu = 1;
        grid = cus * (per_cu < 1 ? per_cu : 1);
    }
    hipMemsetAsync(ctrl, 0, 65536, stream);
    hipLaunchKernelGGL(fwd_kernel, dim3(grid), dim3(512), DYN_LDS, stream, p);
}
```

```cpp
#include <hip/hip_runtime.h>
#include <stdint.h>

typedef unsigned short bf16_t;
typedef short bf16x8 __attribute__((ext_vector_type(8)));
typedef float f32x4 __attribute__((ext_vector_type(4)));
typedef float f32x16 __attribute__((ext_vector_type(16)));
typedef unsigned u32x4 __attribute__((ext_vector_type(4)));
typedef unsigned u32x2 __attribute__((ext_vector_type(2)));

#define D_MODEL 1024
#define BATCH 32
#define SEQ 2048
#define DEPTH 4
#define CTXL 256
#define TL (BATCH * SEQ)
#define TC (BATCH * CTXL)
#define TT (TL + TC)
#define SEQA (SEQ + CTXL)
#define IN_COLS 2400
#define PLD 2432
#define PC_CQ 0
#define PC_KR 192
#define PC_CKV 256
#define PC_NAQ 384
#define PC_NAK 640
#define PC_NAV 896
#define PC_U 1152
#define PC_RQ 1408
#define PC_RK 1664
#define PC_RV 1920
#define PC_RG 2176
#define NEXP 32
#define MOE_FF 512
#define CAP_ROWS 155648
#define WIN_N 2560
#define S5CH 32
#define S5NCH 72

#define XB_TMO      128
#define XB_XCNT(j)  (256  + 64 * (j))
#define XB_XSUB(j)  (1280 + 64 * (j))
#define XB_XGEN(j)  (2304 + 64 * (j))
#define XB_TOP      3328
#define XB_TOPGEN   3392
#define XCD_BAR_WORDS 3456
#define XB_SPIN_CAP (1u << 22)
#define LAS __attribute__((address_space(3)))

__device__ __forceinline__ unsigned xb_ld(unsigned* p)              { return __hip_atomic_load(p, __ATOMIC_RELAXED, __HIP_MEMORY_SCOPE_AGENT); }
__device__ __forceinline__ unsigned xb_add(unsigned* p, unsigned v) { return __hip_atomic_fetch_add(p, v, __ATOMIC_RELAXED, __HIP_MEMORY_SCOPE_AGENT); }
__device__ __forceinline__ unsigned xb_xcc_id() { return (unsigned)__builtin_amdgcn_s_getreg((3 << 11) | 20) & 0xFu; }
#define XB_SPIN(cond, bar) do { unsigned _sp = 0; while (cond) { __builtin_amdgcn_s_sleep(1); \
    if ((++_sp & 255u) == 0u) { if (xb_ld(&(bar)[XB_TMO])) break; if (_sp > XB_SPIN_CAP) { atomicAdd(&(bar)[XB_TMO], 1u); break; } } } } while (0)

struct XcdBarrier { unsigned* bar; unsigned x; volatile LAS unsigned* st; };

__device__ __forceinline__ XcdBarrier xcd_barrier_post(unsigned* bar, volatile LAS unsigned* st) {
    XcdBarrier b; b.bar = bar; b.x = xb_xcc_id(); b.st = st;
    if (threadIdx.x == 0) (void)xb_add(&bar[XB_XCNT(b.x)], 1u);
    return b;
}
__device__ __forceinline__ void xcd_barrier_complete(unsigned* bar, unsigned x, unsigned& nloc, unsigned& nx) {
    const unsigned G = gridDim.x * gridDim.y * gridDim.z;
    unsigned sum, cnt, mine, sp = 0u;
    for (;;) {
        sum = 0u; cnt = 0u; mine = 0u;
#pragma unroll
        for (unsigned j = 0; j < 16; ++j) { const unsigned c = xb_ld(&bar[XB_XCNT(j)]); sum += c; cnt += (c > 0u) ? 1u : 0u; mine = (j == x) ? c : mine; }
        if (sum == G) break;
        __builtin_amdgcn_s_sleep(1);
        if ((++sp & 255u) == 0u) { if (xb_ld(&bar[XB_TMO])) break; if (sp > XB_SPIN_CAP) { atomicAdd(&bar[XB_TMO], 1u); break; } }
    }
    nloc = mine > 0u ? mine : 1u; nx = cnt > 0u ? cnt : 1u;
}
__device__ __forceinline__ void xcd_barrier(const XcdBarrier& b) {
    asm volatile("s_waitcnt vmcnt(0)" ::: "memory");
    __syncthreads();
    if (threadIdx.x == 0) {
        unsigned* bar = b.bar;
        unsigned bx = b.x; asm volatile("" : "+s"(bx));
        __builtin_amdgcn_s_waitcnt(0);
        unsigned nloc = b.st[0], nx = b.st[1];
        if (nloc == 0u) { xcd_barrier_complete(bar, bx, nloc, nx); b.st[0] = nloc; b.st[1] = nx; }
        const unsigned old = xb_add(&bar[XB_XSUB(bx)], 1u);
        const unsigned gen = old / nloc;
        if (old + 1u == (gen + 1u) * nloc) {
            __builtin_amdgcn_fence(__ATOMIC_RELEASE, "agent");
            asm volatile("s_waitcnt vmcnt(0)" ::: "memory");
            const unsigned og = xb_add(&bar[XB_TOP], 1u);
            const unsigned tg = og / nx;
            if (og + 1u == (tg + 1u) * nx) xb_add(&bar[XB_TOPGEN], 1u);
            else XB_SPIN(xb_ld(&bar[XB_TOPGEN]) == tg, bar);
            __builtin_amdgcn_fence(__ATOMIC_ACQUIRE, "agent");
            xb_add(&bar[XB_XGEN(bx)], 1u);
            asm volatile("s_waitcnt vmcnt(0)" ::: "memory");
        } else {
            XB_SPIN(xb_ld(&bar[XB_XGEN(bx)]) == gen, bar);
            __builtin_amdgcn_fence(__ATOMIC_ACQUIRE, "agent");
            asm volatile("s_waitcnt vmcnt(0)" ::: "memory");
        }
    }
    __syncthreads();
}

__device__ __forceinline__ int otid() { int t = threadIdx.x & 255; asm volatile("" : "+v"(t)); return t; }
__device__ __forceinline__ int rtid() { int t = threadIdx.x; asm volatile("" : "+v"(t)); return t; }
#define VB ((int)(blockIdx.x * 2 + (rtid() >> 8)))
#define NVB ((int)(gridDim.x * 2))
#define VBX ((int)(gridDim.x == 256 ? (((blockIdx.x & 7) << 6) | ((blockIdx.x >> 3) << 1) | (rtid() >> 8)) : (blockIdx.x * 2 + (rtid() >> 8))))
__device__ __forceinline__ float bf2f(bf16_t v) { return __uint_as_float(((unsigned)v) << 16); }
__device__ __forceinline__ bf16_t f2bf(float f) { unsigned u = __float_as_uint(f); u += 0x7fffu + ((u >> 16) & 1u); return (bf16_t)(u >> 16); }
typedef float f32x2_ __attribute__((ext_vector_type(2)));
typedef __bf16 bf16x2_ __attribute__((ext_vector_type(2)));
__device__ __forceinline__ unsigned pk2(float lo, float hi) { const f32x2_ v = {lo, hi}; const bf16x2_ b = __builtin_convertvector(v, bf16x2_); return __builtin_bit_cast(unsigned, b); }
__device__ __forceinline__ float lo2f(unsigned u) { return __uint_as_float(u << 16); }
__device__ __forceinline__ float hi2f(unsigned u) { return __uint_as_float(u & 0xffff0000u); }
__device__ __forceinline__ float silu_f(float x) { return x * __builtin_amdgcn_rcpf(1.0f + __expf(-x)); }
__device__ __forceinline__ float sigmoid_f(float x) { return __builtin_amdgcn_rcpf(1.0f + __expf(-x)); }
__device__ __forceinline__ float gelu_tanh(float x) { const float u = 0.7978845608028654f * (x + 0.044715f * x * x * x); const float t = 1.0f - 2.0f * __builtin_amdgcn_rcpf(1.0f + __expf(2.0f * u)); return 0.5f * x * (1.0f + t); }
__device__ __forceinline__ float xh32_max(float x) { const auto rr = __builtin_amdgcn_permlane32_swap(__float_as_uint(x), __float_as_uint(x), false, false); return __builtin_fmaxf(__uint_as_float(rr[0]), __uint_as_float(rr[1])); }
__device__ __forceinline__ float xh32_sum(float x) { const auto rr = __builtin_amdgcn_permlane32_swap(__float_as_uint(x), __float_as_uint(x), false, false); return __uint_as_float(rr[0]) + __uint_as_float(rr[1]); }
__device__ __forceinline__ float xh16_max(float x) { const auto rr = __builtin_amdgcn_permlane16_swap(__float_as_uint(x), __float_as_uint(x), false, false); return __builtin_fmaxf(__uint_as_float(rr[0]), __uint_as_float(rr[1])); }
__device__ __forceinline__ float xh16_sum(float x) { const auto rr = __builtin_amdgcn_permlane16_swap(__float_as_uint(x), __float_as_uint(x), false, false); return __uint_as_float(rr[0]) + __uint_as_float(rr[1]); }
template <int CTRL> __device__ __forceinline__ float dpp_f(float v) { return __int_as_float(__builtin_amdgcn_update_dpp(0, __float_as_int(v), CTRL, 0xF, 0xF, false)); }
__device__ __forceinline__ float wave_sum(float v) {
    v += dpp_f<0xB1>(v);
    v += dpp_f<0x4E>(v);
    v += dpp_f<0x141>(v);
    v += dpp_f<0x140>(v);
    v = xh16_sum(v);
    return xh32_sum(v);
}
#define R3_S5SLOC   0ull
#define R3_S5HIN    37748736ull
#define R3_S5G      (R3_S5HIN + 18874368ull)
#define R3_MLAQ     (R3_S5G + 37748736ull)
#define R3_MLAK     (R3_MLAQ + 56623104ull)
#define R3_MLAV     (R3_MLAK + 37748736ull)
#define R3_RETYI    (R3_MLAV + 37748736ull)
#define R3_RETRS    (R3_RETYI + 75497472ull)
#define R3_RETRIN   (R3_RETRS + 75497472ull)
#define R3_NAVT     (R3_RETRIN + 37748736ull)
#define R3_END      (R3_NAVT + 37748736ull)
#define R3_BYTES    453000000ull

constexpr size_t wsal(size_t v) { return (v + 255) & ~(size_t)255; }
constexpr size_t WO_bar = 0;
constexpr size_t WO_mod = wsal(WO_bar + (65536));
constexpr size_t WO_ropeM = wsal(WO_mod + ((size_t)DEPTH * 33 * 6144 * 4));
constexpr size_t WO_ropeR = wsal(WO_ropeM + (2048 * 16 * 2 * 4));
constexpr size_t WO_s5pw = wsal(WO_ropeR + (2048 * 32 * 2 * 4));
constexpr size_t WO_s5bb = wsal(WO_s5pw + ((size_t)DEPTH * 16 * 2 * 33 * 128 * 4));
constexpr size_t WO_s5kt = wsal(WO_s5bb + ((size_t)DEPTH * 16 * 2 * 64 * 32 * 4));
constexpr size_t WO_s5ws = wsal(WO_s5kt + ((size_t)DEPTH * 16 * 2 * 32 * 256 * 4));
constexpr size_t WO_s5wo = wsal(WO_s5ws + ((size_t)DEPTH * 16 * 256 * 512 * 2));
constexpr size_t WO_win_t = wsal(WO_s5wo + ((size_t)DEPTH * 16 * 512 * 768 * 2));
constexpr size_t WO_wout_t = wsal(WO_win_t + ((size_t)DEPTH * WIN_N * 1024 * 2));
constexpr size_t WO_wuq_t = wsal(WO_wout_t + ((size_t)DEPTH * 1024 * 1024 * 2));
constexpr size_t WO_wukv_t = wsal(WO_wuq_t + ((size_t)DEPTH * 384 * 192 * 2));
constexpr size_t WO_wglu_t = wsal(WO_wukv_t + ((size_t)DEPTH * 512 * 128 * 2));
constexpr size_t WO_wr_t = wsal(WO_wglu_t + ((size_t)DEPTH * 256 * 256 * 2));
constexpr size_t WO_w13_t = wsal(WO_wr_t + ((size_t)DEPTH * 128 * 3072 * 2));
constexpr size_t WO_w2_t = wsal(WO_w13_t + ((size_t)32 * 1024 * 1024 * 2));
constexpr size_t WO_xc = wsal(WO_w2_t + ((size_t)32 * 1024 * 512 * 2));
constexpr size_t WO_R1 = wsal(WO_xc + ((size_t)TC * 1024 * 4));
constexpr size_t WO_R2 = wsal(WO_R1 + ((size_t)TT * PLD * 2));
constexpr size_t WO_R3 = wsal(WO_R2 + ((size_t)TT * 1024 * 2));
constexpr size_t WO_route_e = wsal(WO_R3 + (R3_BYTES));
constexpr size_t WO_route_p = wsal(WO_route_e + ((size_t)TT * 2 * 4));
constexpr size_t WO_route_g = wsal(WO_route_p + ((size_t)TT * 2 * 4));
constexpr size_t WO_elist = wsal(WO_route_g + ((size_t)TT * 2 * 4));
constexpr size_t WS_TOTAL = wsal(WO_elist + ((size_t)32 * TT * 4));
struct Params {
    const float *x, *c, *ctx, *c_ctx, *w_mod, *b_mod, *g_mix, *g_ffn, *w_in, *mla_g_cq, *mla_g_ckv, *mla_w_uq, *mla_w_ukv, *na_rpb;
    const float *s5_a_re, *s5_a_im, *s5_log_dt, *s5_b_re, *s5_b_im, *s5_c_re, *s5_c_im, *s5_d, *s5_w_glu, *s5_b_glu, *ret_log_decay, *w_out;
    const float *moe_w_group, *moe_b_group, *moe_w_expert, *moe_b_expert, *moe_w1, *moe_w3, *moe_w2, *g_final;
    float* out;
    char* ws;
    __device__ __forceinline__ unsigned* bar_() const { return (unsigned*)(ws + WO_bar); }
    __device__ __forceinline__ float* mod_() const { return (float*)(ws + WO_mod); }
    __device__ __forceinline__ float* ropeM_() const { return (float*)(ws + WO_ropeM); }
    __device__ __forceinline__ float* ropeR_() const { return (float*)(ws + WO_ropeR); }
    __device__ __forceinline__ float* s5pw_() const { return (float*)(ws + WO_s5pw); }
    __device__ __forceinline__ float* s5bb_() const { return (float*)(ws + WO_s5bb); }
    __device__ __forceinline__ float* s5kt_() const { return (float*)(ws + WO_s5kt); }
    __device__ __forceinline__ bf16_t* s5ws_() const { return (bf16_t*)(ws + WO_s5ws); }
    __device__ __forceinline__ bf16_t* s5wo_() const { return (bf16_t*)(ws + WO_s5wo); }
    __device__ __forceinline__ bf16_t* win_t_() const { return (bf16_t*)(ws + WO_win_t); }
    __device__ __forceinline__ bf16_t* wout_t_() const { return (bf16_t*)(ws + WO_wout_t); }
    __device__ __forceinline__ bf16_t* wuq_t_() const { return (bf16_t*)(ws + WO_wuq_t); }
    __device__ __forceinline__ bf16_t* wukv_t_() const { return (bf16_t*)(ws + WO_wukv_t); }
    __device__ __forceinline__ bf16_t* wglu_t_() const { return (bf16_t*)(ws + WO_wglu_t); }
    __device__ __forceinline__ bf16_t* wr_t_() const { return (bf16_t*)(ws + WO_wr_t); }
    __device__ __forceinline__ bf16_t* w13_t_() const { return (bf16_t*)(ws + WO_w13_t); }
    __device__ __forceinline__ bf16_t* w2_t_() const { return (bf16_t*)(ws + WO_w2_t); }
    __device__ __forceinline__ float* xc_() const { return (float*)(ws + WO_xc); }
    __device__ __forceinline__ bf16_t* R1_() const { return (bf16_t*)(ws + WO_R1); }
    __device__ __forceinline__ bf16_t* R2_() const { return (bf16_t*)out; }
    __device__ __forceinline__ bf16_t* UG_() const { return (bf16_t*)((char*)out + (size_t)TT * 1024 * 2); }
    __device__ __forceinline__ bf16_t* XB_() const { return (bf16_t*)(ws + WO_R2); }
    __device__ __forceinline__ char* R3_() const { return (char*)(ws + WO_R3); }
    __device__ __forceinline__ int* route_e_() const { return (int*)(ws + WO_route_e); }
    __device__ __forceinline__ int* route_p_() const { return (int*)(ws + WO_route_p); }
    __device__ __forceinline__ float* route_g_() const { return (float*)(ws + WO_route_g); }
    __device__ __forceinline__ int* elist_() const { return (int*)(ws + WO_elist); }
    __device__ __forceinline__ int* ecnt_() const { return (int*)(ws + WO_bar + 16384); }
};
#define HID_OFF_ELEMS ((size_t)(TT + 1) * 1024)

#define GEMM_LDS_BYTES (65536 + 512)
template <bool TRANS, bool ROWSS, class AF, class BF>
__device__ __forceinline__ void gemm128(const AF& af, const BF& bf, const int K, f32x4 (&acc)[4][4], char* smem) {
    const int tid = otid(), wid = tid >> 6, lane = tid & 63, wr = wid >> 1, wc = wid & 1, fr = lane & 15, fq = lane >> 4;
    float* SS = (float*)(smem + 65536);
#pragma unroll
    for (int m = 0; m < 4; ++m)
#pragma unroll
        for (int n = 0; n < 4; ++n) acc[m][n] = (f32x4){0.f, 0.f, 0.f, 0.f};
    const int r0 = tid >> 2, c0 = ((tid & 3) ^ ((4 - ((r0 >> 2) & 3)) & 3)) * 8;
    const int rdsw = (fq ^ ((4 - ((fr >> 2) & 3)) & 3)) * 16;
    float ss0 = 0.f, ss1 = 0.f;
    auto stage = [&](int kt, int buf) {
        char* base = smem + buf * 32768 + tid * 16;
#pragma unroll
        for (int sub = 0; sub < 2; ++sub) {
            __builtin_amdgcn_global_load_lds((const unsigned*)af(r0, kt + sub * 32 + c0), (unsigned*)(base + sub * 8192), 16, 0, 0);
            __builtin_amdgcn_global_load_lds((const unsigned*)af(r0 + 64, kt + sub * 32 + c0), (unsigned*)(base + sub * 8192 + 4096), 16, 0, 0);
            __builtin_amdgcn_global_load_lds((const unsigned*)bf(r0, kt + sub * 32 + c0), (unsigned*)(base + 16384 + sub * 8192), 16, 0, 0);
            __builtin_amdgcn_global_load_lds((const unsigned*)bf(r0 + 64, kt + sub * 32 + c0), (unsigned*)(base + 16384 + sub * 8192 + 4096), 16, 0, 0);
        }
    };
    stage(0, 0);
    asm volatile("s_waitcnt vmcnt(0)" ::: "memory");
    __syncthreads();
    for (int kt = 0, it = 0; kt < K; kt += 64, ++it) {
        const int cur = it & 1;
        if (kt + 64 < K) stage(kt + 64, cur ^ 1);
        const char* SA = smem + cur * 32768; const char* SB = SA + 16384;
#pragma unroll
        for (int sub = 0; sub < 2; ++sub) {
            bf16x8 At[4], Bt[4];
#pragma unroll
            for (int m = 0; m < 4; ++m) At[m] = *(const bf16x8*)(SA + sub * 8192 + (wr * 64 + m * 16 + fr) * 64 + rdsw);
#pragma unroll
            for (int n = 0; n < 4; ++n) Bt[n] = *(const bf16x8*)(SB + sub * 8192 + (wc * 64 + n * 16 + fr) * 64 + rdsw);
            if (ROWSS) {
                const bf16x8 v0 = *(const bf16x8*)(SA + sub * 8192 + tid * 16), v1 = *(const bf16x8*)(SA + sub * 8192 + 4096 + tid * 16);
#pragma unroll
                for (int j = 0; j < 8; ++j) { const float a = bf2f((bf16_t)v0[j]), b = bf2f((bf16_t)v1[j]); ss0 += a * a; ss1 += b * b; }
            }
#pragma unroll
            for (int m = 0; m < 4; ++m)
#pragma unroll
                for (int n = 0; n < 4; ++n) {
                    if (TRANS) acc[m][n] = __builtin_amdgcn_mfma_f32_16x16x32_bf16(Bt[n], At[m], acc[m][n], 0, 0, 0);
                    else       acc[m][n] = __builtin_amdgcn_mfma_f32_16x16x32_bf16(At[m], Bt[n], acc[m][n], 0, 0, 0);
                }
        }
        asm volatile("s_waitcnt vmcnt(0)" ::: "memory");
        __syncthreads();
    }
    if (ROWSS) {
        ss0 += dpp_f<0xB1>(ss0); ss0 += dpp_f<0x4E>(ss0);
        ss1 += dpp_f<0xB1>(ss1); ss1 += dpp_f<0x4E>(ss1);
        if ((tid & 3) == 0) { SS[r0] = ss0; SS[r0 + 64] = ss1; }
        __syncthreads();
    }
    (void)wr; (void)wc;
}
#define GEMM_SS(smem) ((const float*)((smem) + 65536))


namespace g8 {
constexpr int BM = 256, BK = 64, HALF = 128, HTB = HALF * BK * 2, NXCD = 8, WGM = 8;
__device__ __forceinline__ int lds_byte(int r, int c) { const int st = (r >> 4) * 2 + (c >> 5), rr = r & 15, cc = c & 31, ob = rr * 64 + cc * 2; return st * 1024 + (ob ^ (((ob >> 9) & 1) << 5)); }
__device__ __forceinline__ void stage_rc(int b, int& R, int& C) { const int st = b / 1024, sb = b % 1024, swz = sb ^ (((sb >> 9) & 1) << 5); R = (st >> 1) * 16 + swz / 64; C = (st & 1) * 32 + (swz % 64) / 2; }
struct Unit { int pm, pn; };
struct StaticOrder {
    int nM, nN, nwg, G, c;
    __device__ void init(int M, int N, int G_, int c_) { nM = M / BM; nN = N / BM; nwg = nM * nN; G = G_; c = c_; }
    __device__ bool next(int i, Unit& u) const {
        const long L = (long)i * G + c; if (L >= nwg) return false;
        int wgid = (int)L; { const int q = nwg / NXCD, r = nwg % NXCD, xcd = wgid % NXCD, off = wgid / NXCD; wgid = (xcd < r ? xcd * (q + 1) : r * (q + 1) + (xcd - r) * q) + off; }
        const int nig = WGM * nN, gid = wgid / nig, fm = gid * WGM, gsz = (nM - fm) < WGM ? (nM - fm) : WGM;
        u.pm = fm + ((wgid % nig) % gsz); u.pn = (wgid % nig) / gsz; return true;
    }
};
template <class Sched, class AOFF, class BOFF, class Epi>
__device__ __forceinline__ void gemm8(LAS unsigned char* lds, const bf16_t* Abase, const bf16_t* Btbase, const int K, const Sched& S, const AOFF& aoff, const BOFF& boffu, const Epi& E) {
    int tz = threadIdx.x; asm volatile("" : "+v"(tz));
    const int tid = tz, wid = tid >> 6, lane = tid & 63, wr = wid >> 2, wc = wid & 3, fr = lane & 15, fq = lane >> 4;
    const int nt = K / BK;
    unsigned voffB[2];
    unsigned va00, va01, va10, va11;
    {   int RA[2], CA[2];
#pragma unroll
        for (int i = 0; i < 2; ++i) { stage_rc(tid * 16 + i * 8192, RA[i], CA[i]); voffB[i] = (unsigned)(RA[i] * K + CA[i]) * 2u; }
        Unit u0; if (!S.next(0, u0)) return;
        va00 = aoff(u0, RA[0]) + CA[0] * 2u; va01 = aoff(u0, RA[1]) + CA[1] * 2u; va10 = aoff(u0, 128 + RA[0]) + CA[0] * 2u; va11 = aoff(u0, 128 + RA[1]) + CA[1] * 2u; }
    const size_t kstep = (size_t)(BK * 2);
    const size_t hstep = (size_t)HALF * K * 2;
    const unsigned ldsw = (unsigned)wid * 1024u;
    const int aoffl = lds_byte(wr * 64 + fr, fq * 8), boffl = lds_byte(wc * 32 + fr, fq * 8);
#define G8_SA(b, h) (((b) * 2 + (h)) * HTB)
#define G8_SB(b, h) ((4 + (b) * 2 + (h)) * HTB)
#define G8_STAGE(bufoff, gbase, v0, v1) do { \
        __builtin_amdgcn_global_load_lds((const unsigned*)((const char*)(gbase) + (v0)), (LAS unsigned*)(lds + (bufoff) + ldsw), 16, 0, 0); \
        __builtin_amdgcn_global_load_lds((const unsigned*)((const char*)(gbase) + (v1)), (LAS unsigned*)(lds + (bufoff) + ldsw + 8192), 16, 0, 0); } while (0)
#define G8_LDA(dst, b, h) do { _Pragma("unroll") for (int m = 0; m < 4; ++m) _Pragma("unroll") for (int k = 0; k < 2; ++k) dst[m][k] = *(const LAS bf16x8*)(lds + G8_SA(b, h) + aoffl + m * 2048 + k * 1024); } while (0)
#define G8_LDB(dst, b, h) do { _Pragma("unroll") for (int n = 0; n < 2; ++n) _Pragma("unroll") for (int k = 0; k < 2; ++k) dst[n][k] = *(const LAS bf16x8*)(lds + G8_SB(b, h) + boffl + n * 2048 + k * 1024); } while (0)
#define G8_MMA(ai, bj, At, Bt) do { __builtin_amdgcn_s_setprio(1); _Pragma("unroll") for (int m = 0; m < 4; ++m) _Pragma("unroll") for (int n = 0; n < 2; ++n) _Pragma("unroll") for (int k = 0; k < 2; ++k) \
        acc[ai][bj][m][n] = __builtin_amdgcn_mfma_f32_16x16x32_bf16(Bt[n][k], At[m][k], acc[ai][bj][m][n], 0, 0, 0); __builtin_amdgcn_s_setprio(0); } while (0)
#define G8_WAIT_V(n) asm volatile("s_waitcnt vmcnt(" #n ")" ::: "memory")
#define G8_WAIT_L(n) asm volatile("s_waitcnt lgkmcnt(" #n ")" ::: "memory")
#define G8_BAR __builtin_amdgcn_s_barrier()
#define G8_SCHED __builtin_amdgcn_sched_barrier(0)
    Unit cur, nxt; int ui = 0;
    if (!S.next(0, cur)) return;
    f32x4 acc[2][2][4][2];
#pragma unroll
    for (int a = 0; a < 2; ++a)
#pragma unroll
        for (int b = 0; b < 2; ++b)
#pragma unroll
            for (int m = 0; m < 4; ++m)
#pragma unroll
                for (int n = 0; n < 2; ++n) acc[a][b][m][n] = (f32x4){0.f, 0.f, 0.f, 0.f};
    bf16x8 At[4][2], B0[2][2], B1[2][2];
    const char* cA = (const char*)Abase; const char* cB = (const char*)Btbase + boffu(cur);
    G8_STAGE(G8_SB(0, 0), cB, voffB[0], voffB[1]); G8_STAGE(G8_SA(0, 0), cA, va00, va01); G8_STAGE(G8_SB(0, 1), cB + hstep, voffB[0], voffB[1]); G8_STAGE(G8_SA(0, 1), cA, va10, va11);
    if (wr == 1) G8_BAR;
    G8_WAIT_V(4); G8_BAR;
    G8_STAGE(G8_SB(1, 0), cB + kstep, voffB[0], voffB[1]); G8_STAGE(G8_SA(1, 0), cA + kstep, va00, va01); G8_STAGE(G8_SB(1, 1), cB + hstep + kstep, voffB[0], voffB[1]);
    G8_WAIT_V(6); G8_BAR;
    for (;;) {
        const bool has_next = S.next(ui + 1, nxt);
        const char* nB = has_next ? (const char*)Btbase + boffu(nxt) : cB;
        for (int t = 0; t < nt; t += 2) {
            const bool last = (t == nt - 2);
            const char* a1 = cA + (size_t)(t + 1) * kstep;
            const char* a2 = last ? cA : cA + (size_t)(t + 2) * kstep; const char* b2 = last ? nB : cB + (size_t)(t + 2) * kstep;
            const char* a3 = a2 + kstep; const char* b3 = b2 + kstep;
            G8_LDB(B0, 0, 0); G8_SCHED; G8_LDA(At, 0, 0); G8_STAGE(G8_SA(1, 1), a1, va10, va11);
            G8_WAIT_L(8); G8_BAR; G8_WAIT_L(0); G8_MMA(0, 0, At, B0); G8_BAR; G8_SCHED;
            if (last && has_next) {
                int tq = threadIdx.x; asm volatile("" : "+v"(tq)); int R0, C0, R1, C1; stage_rc(tq * 16, R0, C0); stage_rc(tq * 16 + 8192, R1, C1);
                va00 = aoff(nxt, R0) + C0 * 2u; va01 = aoff(nxt, R1) + C1 * 2u; va10 = aoff(nxt, 128 + R0) + C0 * 2u; va11 = aoff(nxt, 128 + R1) + C1 * 2u; }
            G8_LDB(B1, 0, 1); G8_STAGE(G8_SB(0, 0), b2, voffB[0], voffB[1]);
            G8_BAR; G8_WAIT_L(0); G8_MMA(0, 1, At, B1); G8_BAR;
            G8_LDA(At, 0, 1); G8_STAGE(G8_SA(0, 0), a2, va00, va01);
            G8_BAR; G8_WAIT_L(0); G8_MMA(1, 0, At, B0); G8_BAR; G8_SCHED;
            G8_STAGE(G8_SB(0, 1), b2 + hstep, voffB[0], voffB[1]);
            G8_WAIT_V(6); G8_BAR; G8_MMA(1, 1, At, B1); G8_BAR;
            G8_LDB(B0, 1, 0); G8_SCHED; G8_LDA(At, 1, 0); G8_STAGE(G8_SA(0, 1), a2, va10, va11);
            G8_WAIT_L(8); G8_BAR; G8_WAIT_L(0); G8_MMA(0, 0, At, B0); G8_BAR; G8_SCHED;
            G8_LDB(B1, 1, 1); G8_STAGE(G8_SB(1, 0), b3, voffB[0], voffB[1]);
            G8_BAR; G8_WAIT_L(0); G8_MMA(0, 1, At, B1); G8_BAR;
            G8_LDA(At, 1, 1); G8_STAGE(G8_SA(1, 0), a3, va00, va01);
            G8_BAR; G8_WAIT_L(0); G8_MMA(1, 0, At, B0); G8_BAR; G8_SCHED;
            G8_STAGE(G8_SB(1, 1), b3 + hstep, voffB[0], voffB[1]);
            G8_WAIT_V(6); G8_BAR; G8_MMA(1, 1, At, B1); G8_BAR;
        }
        { int te = threadIdx.x; asm volatile("" : "+v"(te)); const int we = te >> 6, le = te & 63; E(acc, cur, we >> 2, we & 3, le & 15, le >> 4); }
        if (!has_next) break;
#pragma unroll
        for (int a = 0; a < 2; ++a)
#pragma unroll
            for (int b = 0; b < 2; ++b)
#pragma unroll
                for (int m = 0; m < 4; ++m)
#pragma unroll
                    for (int n = 0; n < 2; ++n) acc[a][b][m][n] = (f32x4){0.f, 0.f, 0.f, 0.f};
        cur = nxt; cB = nB; ++ui;
    }
    G8_WAIT_V(0);
    if (wr == 0) G8_BAR;
    G8_BAR;
#undef G8_SA
#undef G8_SB
#undef G8_STAGE
#undef G8_LDA
#undef G8_LDB
#undef G8_MMA
#undef G8_WAIT_V
#undef G8_WAIT_L
#undef G8_BAR
#undef G8_SCHED
}
}

__device__ __forceinline__ int conv_items(int Nout, int Krows) { return ((Nout + 255) / 256) * (Krows / 8); }
template <class MAP>
__device__ __forceinline__ void conv_do(int item, const float* W, int ldw, int Krows, bf16_t* Wt, int Nout, const float* ks, const MAP& map) {
    const int nblk = (Nout + 255) / 256;
    const int kb = item / nblk, nb = item % nblk;
    const int n = nb * 256 + otid();
    if (n >= Nout) return;
    int src; float sc; map(n, src, sc);
    u32x4 o;
    if (src < 0) { o = (u32x4){0u, 0u, 0u, 0u}; }
    else {
        float v[8];
#pragma unroll
        for (int j = 0; j < 8; ++j) v[j] = __builtin_nontemporal_load(W + (size_t)(kb * 8 + j) * ldw + src) * (ks ? sc * ks[kb * 8 + j] : sc);
        o.x = pk2(v[0], v[1]); o.y = pk2(v[2], v[3]); o.z = pk2(v[4], v[5]); o.w = pk2(v[6], v[7]);
    }
    *(u32x4*)(Wt + (size_t)n * Krows + kb * 8) = o;
}

#define CT_STRIDE 272
template <class COLF>
__device__ __forceinline__ void conv_tile(int n0, int k0, int ldw, int Krows, bf16_t* Wt, const float* ks, const COLF& colf, char* smem) {
    const int tid = otid(), nl = tid & 63, kr = tid >> 6;
    const float* cp; float sc; colf(n0 + nl, cp, sc);
    __syncthreads();
    float vv[32];
#pragma unroll
    for (int q = 0; q < 32; ++q) { const int k = k0 + q * 4 + kr; vv[q] = cp ? __builtin_nontemporal_load(cp + (size_t)k * ldw) : 0.f; }
#pragma unroll
    for (int q = 0; q < 32; ++q) {
        const int k = k0 + q * 4 + kr;
        *(bf16_t*)(smem + nl * CT_STRIDE + (q * 4 + kr) * 2) = f2bf(vv[q] * (ks ? sc * ks[k] : sc));
    }
    __syncthreads();
#pragma unroll
    for (int i = 0; i < 4; ++i) {
        const int pid = i * 256 + tid, row = pid >> 4, c = pid & 15;
        *(u32x4*)(Wt + (size_t)(n0 + row) * Krows + k0 + c * 8) = *(const u32x4*)(smem + row * CT_STRIDE + c * 16);
    }
}
__device__ __forceinline__ int ct_items(int Nout, int Krows) { return (Nout / 64) * (Krows / 128); }

struct MapWin { __device__ __forceinline__ void operator()(int n, int& src, float& sc) const {
    sc = 1.0f;
    if (n < 192) src = n;
    else if (n < 224) { const int j = n - 192, pi = j >> 1, s = j & 1; src = 320 + pi + 8 * (pi >= 8) + 8 * s; }
    else if (n < 256) src = -1;
    else if (n < 384) src = 192 + (n - 256);
    else if (n < 640) { src = 352 + (n - 384); sc = 0.125f * 1.4426950408889634f; }
    else if (n < 896) src = 608 + (n - 640);
    else if (n < 1152) src = 864 + (n - 896);
    else if (n < 1408) src = 1120 + (n - 1152);
    else if (n < 1920) { const int rk = n >= 1664; const int j = n - (rk ? 1664 : 1408), h = j >> 6, jj = j & 63, pi = jj >> 1, s = jj & 1;
                         src = (rk ? 1632 : 1376) + h * 64 + pi + 16 * (pi >= 16) + 16 * s; sc = rk ? 0.125f : 1.0f; }
    else if (n < 2176) src = 1888 + (n - 1920);
    else if (n < 2432) src = 2144 + (n - 2176);
    else src = -1;
} };
struct MapIdent { __device__ __forceinline__ void operator()(int n, int& src, float& sc) const { src = n; sc = 1.0f; } };
struct MapWuq { __device__ __forceinline__ void operator()(int n, int& src, float& sc) const {
    const int h = n / 96, j = n % 96; sc = 0.10206207261596577f * 1.4426950408889634f;
    if (j < 64) src = h * 96 + j; else { const int pi = (j - 64) >> 1, s = (j - 64) & 1; src = h * 96 + 64 + pi + 8 * (pi >= 8) + 8 * s; }
} };
struct MapWukv { __device__ __forceinline__ void operator()(int n, int& src, float& sc) const {
    sc = 1.0f; if (n < 256) src = (n >> 6) * 128 + (n & 63); else { const int m = n - 256; src = (m >> 6) * 128 + 64 + (m & 63); }
} };

__device__ __forceinline__ void phase_pa(const Params& p, char* smem) {
    const int tid = otid();
    const int n_win = conv_items(WIN_N, 1024), n_wout = conv_items(1024, 1024), n_wuq = conv_items(384, 192), n_wukv = conv_items(512, 128), n_wglu = conv_items(256, 256);
    const int s0 = DEPTH * n_win, s1 = s0 + DEPTH * n_wout, s2 = s1 + DEPTH * n_wuq, s3 = s2 + DEPTH * n_wukv, s4 = s3 + DEPTH * n_wglu;
    const int s5 = s4 + DEPTH * 96, s6 = s5 + 384, s7 = s6 + DEPTH * 32, s8 = s7 + DEPTH * 128 * 2048 / 8 / 256;
    for (int it = VB; it < s8; it += NVB) {
        if (it >= s7) {
            const int idx = (it - s7) * 256 + tid;
            const int k8 = idx % 256, n = (idx / 256) & 127, l = idx / (256 * 128);
            u32x4 o = (u32x4){0u, 0u, 0u, 0u};
            const int kk = (k8 * 8) & 1023, seg = (k8 * 8) >> 10, nn = n < 36 ? n : n - 36;
            if (n < 36 || (n < 72 && seg == 0)) {
                float v[8];
#pragma unroll
                for (int q = 0; q < 8; ++q) {
                    const float w = nn < 4 ? p.moe_w_group[((size_t)l * 1024 + kk + q) * 4 + nn] : p.moe_w_expert[((size_t)l * 1024 + kk + q) * 32 + (nn - 4)];
                    const float hi = bf2f(f2bf(w)); v[q] = n < 36 ? hi : w - hi;
                }
                o.x = pk2(v[0], v[1]); o.y = pk2(v[2], v[3]); o.z = pk2(v[4], v[5]); o.w = pk2(v[6], v[7]);
            }
            *(u32x4*)(p.wr_t_() + ((size_t)l * 128 + n) * 2048 + k8 * 8) = o;
            continue;
        }
        if (it < s0) { const int l = it / n_win; conv_do(it % n_win, p.w_in + (size_t)l * 1024 * IN_COLS, IN_COLS, 1024, p.win_t_() + (size_t)l * WIN_N * 1024, WIN_N, nullptr, MapWin()); }
        else if (it < s1) { const int j = it - s0, l = j / n_wout; conv_do(j % n_wout, p.w_out + (size_t)l * 1024 * 1024, 1024, 1024, p.wout_t_() + (size_t)l * 1024 * 1024, 1024, nullptr, MapIdent()); }
        else if (it < s2) { const int j = it - s1, l = j / n_wuq; conv_do(j % n_wuq, p.mla_w_uq + (size_t)l * 192 * 384, 384, 192, p.wuq_t_() + (size_t)l * 384 * 192, 384, p.mla_g_cq + l * 192, MapWuq()); }
        else if (it < s3) { const int j = it - s2, l = j / n_wukv; conv_do(j % n_wukv, p.mla_w_ukv + (size_t)l * 128 * 512, 512, 128, p.wukv_t_() + (size_t)l * 512 * 128, 512, p.mla_g_ckv + l * 128, MapWukv()); }
        else if (it < s4) { const int j = it - s3, l = j / n_wglu; conv_do(j % n_wglu, p.s5_w_glu + (size_t)l * 256 * 256, 256, 256, p.wglu_t_() + (size_t)l * 256 * 256, 256, nullptr, MapIdent()); }
        else if (it < s5) {
            const int j = it - s4, l = j / 96, cg = j % 96;
            const int col = cg * 64 + (tid & 63), kq = __builtin_amdgcn_readfirstlane(tid >> 6);
            float acc[33];
#pragma unroll
            for (int r = 0; r < 33; ++r) acc[r] = 0.f;
            const float* W = p.w_mod + (size_t)l * 1024 * 6144 + col;
            const int ln = tid & 63;
#pragma unroll 1
            for (int k0 = kq * 256; k0 < kq * 256 + 256; k0 += 64) {
                float car[33];
#pragma unroll
                for (int r = 0; r < 33; ++r) car[r] = silu_f(r < 32 ? p.c[r * 1024 + k0 + ln] : p.c_ctx[k0 + ln]);
#pragma unroll 2
                for (int j = 0; j < 64; ++j) {
                    const float w = __builtin_nontemporal_load(W + (size_t)(k0 + j) * 6144);
#pragma unroll
                    for (int r = 0; r < 33; ++r) acc[r] += __int_as_float(__builtin_amdgcn_readlane(__float_as_int(car[r]), j)) * w;
                }
            }
            float* red = (float*)smem;
            __syncthreads();
#pragma unroll
            for (int r = 0; r < 33; ++r) red[(kq * 33 + r) * 64 + (tid & 63)] = acc[r];
            __syncthreads();
            if (tid < 64) {
                const float bm = p.b_mod[l * 6144 + col];
#pragma unroll
                for (int r = 0; r < 33; ++r) {
                    const float v = red[(0 * 33 + r) * 64 + tid] + red[(1 * 33 + r) * 64 + tid] + red[(2 * 33 + r) * 64 + tid] + red[(3 * 33 + r) * 64 + tid];
                    p.mod_()[((size_t)l * 33 + r) * 6144 + col] = v + bm;
                }
            }
            __syncthreads();
        }
        else if (it < s6) {
            const int idx = (it - s5) * 256 + tid;
            if (idx < 2048 * 16) {
                const int t = idx >> 4, pi = idx & 15;
                const double inv = pow(10000.0, -(double)(pi & 7) / 8.0);
                const double ang = (double)(pi < 8 ? (t >> 6) : (t & 63)) * inv;
                p.ropeM_()[idx * 2] = (float)cos(ang); p.ropeM_()[idx * 2 + 1] = (float)sin(ang);
            } else {
                const int i2 = idx - 2048 * 16, t = i2 >> 5, pi = i2 & 31;
                const double inv = pow(10000.0, -(double)(pi & 15) / 16.0);
                const double ang = (double)(pi < 16 ? (t >> 6) : (t & 63)) * inv;
                p.ropeR_()[i2 * 2] = (float)cos(ang); p.ropeR_()[i2 * 2 + 1] = (float)sin(ang);
            }
        }
        else {
            const int j = it - s6, l = j >> 5, g = (j >> 1) & 15, dir = j & 1;
            if (tid < 64) {
                const int pp = tid;
                const size_t ai = (((size_t)l * 2 + dir) * 16 + g) * 64 + pp;
                const double are = p.s5_a_re[ai], aim = p.s5_a_im[ai];
                const double dt = exp((double)p.s5_log_dt[(l * 2 + dir) * 16 + g]);
                const double ldr = are * dt, ldi = aim * dt;
                float* PW = p.s5pw_() + ((((size_t)l * 16 + g) * 2 + dir) * 33) * 128;
                for (int n = 0; n <= 32; ++n) { const double mg = exp(ldr * n); PW[n * 128 + pp * 2] = (float)(mg * cos(ldi * n)); PW[n * 128 + pp * 2 + 1] = (float)(mg * sin(ldi * n)); }
                const double mg = exp(ldr), abr = mg * cos(ldi), abi = mg * sin(ldi);
                const double nr = abr - 1.0, ni = abi, den = are * are + aim * aim;
                const double fre = (nr * are + ni * aim) / den, fim = (ni * are - nr * aim) / den;
                float* BB = p.s5bb_() + ((((size_t)l * 16 + g) * 2 + dir) * 64 + pp) * 32;
                for (int ci = 0; ci < 16; ++ci) {
                    const double br = p.s5_b_re[ai * 16 + ci], bi = p.s5_b_im[ai * 16 + ci];
                    BB[ci * 2] = (float)(fre * br - fim * bi); BB[ci * 2 + 1] = (float)(fre * bi + fim * br);
                }
            }
        }
    }
}

__device__ __forceinline__ void phase_pb(const Params& p) {
    const int tid = otid();
    for (int it = VB; it < DEPTH * 16 * 2 * 32; it += NVB) {
        const int j = it & 31, dir = (it >> 5) & 1, g = (it >> 6) & 15, l = it >> 10;
        const int co = tid >> 4, ci = tid & 15;
        const float* PW = p.s5pw_() + ((((size_t)l * 16 + g) * 2 + dir) * 33 + j) * 128;
        const float* BB = p.s5bb_() + (((size_t)l * 16 + g) * 2 + dir) * 64 * 32;
        const size_t cb = ((((size_t)l * 2 + dir) * 16 + g) * 16 + co) * 64;
        float acc = 0.f;
        for (int pp = 0; pp < 64; ++pp) {
            const float cr = p.s5_c_re[cb + pp], cim = p.s5_c_im[cb + pp];
            const float ar = PW[pp * 2], ai = PW[pp * 2 + 1];
            const float br = BB[pp * 32 + ci * 2], bi = BB[pp * 32 + ci * 2 + 1];
            const float mr = cr * ar - cim * ai, mi = cr * ai + cim * ar;
            acc += mr * br - mi * bi;
        }
        p.s5kt_()[(size_t)it * 256 + tid] = acc;
    }
}

__device__ __forceinline__ void phase_pc(const Params& p) {
    const int tid = otid();
    const int nA = DEPTH * 16 * 64, nB = DEPTH * 16 * 192;
    for (int it = VB; it < nA + nB; it += NVB) {
        if (it < nA) {
            const int lg = it >> 6, sub = it & 63;
            const int idx = sub * 256 + tid, n = idx >> 6, k8 = idx & 63;
            const int dir = n >> 7, part = (n >> 6) & 1, pp = n & 63;
            const int s = k8 >> 1, ci0 = (k8 & 1) * 8;
            const int e = dir == 0 ? 31 - s : s;
            const float* PW = p.s5pw_() + (((size_t)lg * 2 + dir) * 33 + e) * 128;
            const float* BB = p.s5bb_() + (((size_t)lg * 2 + dir) * 64 + pp) * 32;
            const float ar = PW[pp * 2], ai = PW[pp * 2 + 1];
            float v[8];
#pragma unroll
            for (int q = 0; q < 8; ++q) { const float br = BB[(ci0 + q) * 2], bi = BB[(ci0 + q) * 2 + 1]; v[q] = part == 0 ? (ar * br - ai * bi) : (ar * bi + ai * br); }
            u32x4 o; o.x = pk2(v[0], v[1]); o.y = pk2(v[2], v[3]); o.z = pk2(v[4], v[5]); o.w = pk2(v[6], v[7]);
            *(u32x4*)(p.s5ws_() + ((size_t)lg * 256 + n) * 512 + k8 * 8) = o;
        } else {
            const int j = it - nA, lg = j / 192, sub = j % 192;
            const int idx = sub * 256 + tid, n = idx / 96, k8 = idx % 96;
            const int t = n >> 4, co = n & 15;
            float v[8];
            if (k8 < 64) {
                const int s = k8 >> 1, ci0 = (k8 & 1) * 8;
                const float* KTf = p.s5kt_() + (((size_t)lg * 2 + 0) * 32) * 256;
                const float* KTb = p.s5kt_() + (((size_t)lg * 2 + 1) * 32) * 256;
#pragma unroll
                for (int q = 0; q < 8; ++q) {
                    float a = 0.f;
                    if (s <= t) a += KTf[(t - s) * 256 + co * 16 + ci0 + q];
                    if (s >= t) a += KTb[(s - t) * 256 + co * 16 + ci0 + q];
                    v[q] = a;
                }
            } else {
                const int q0 = (k8 - 64) * 8, dir = q0 >> 7, part = (q0 >> 6) & 1, p0 = q0 & 63;
                const int l = lg >> 4, g = lg & 15;
                const int e = dir == 0 ? t + 1 : 32 - t;
                const float* PW = p.s5pw_() + (((size_t)lg * 2 + dir) * 33 + e) * 128;
                const size_t cb = ((((size_t)l * 2 + dir) * 16 + g) * 16 + co) * 64;
#pragma unroll
                for (int q = 0; q < 8; ++q) {
                    const int pp = p0 + q;
                    const float cr = p.s5_c_re[cb + pp], cim = p.s5_c_im[cb + pp], ar = PW[pp * 2], ai = PW[pp * 2 + 1];
                    v[q] = part == 0 ? (cr * ar - cim * ai) : -(cr * ai + cim * ar);
                }
            }
            u32x4 o; o.x = pk2(v[0], v[1]); o.y = pk2(v[2], v[3]); o.z = pk2(v[4], v[5]); o.w = pk2(v[6], v[7]);
            *(u32x4*)(p.s5wo_() + ((size_t)lg * 512 + n) * 768 + k8 * 8) = o;
        }
    }
}

__device__ __forceinline__ const float* mod_row(const Params& p, int layer, int tk) { return p.mod_() + ((size_t)layer * 33 + (tk < TL ? (tk >> 11) : 32)) * 6144; }
__device__ __forceinline__ void expert_prefix(const Params& p, int layer, int* pblk) {
    __syncthreads();
    if (otid() == 0) { int a = 0; for (int e = 0; e < 32; ++e) { pblk[e] = a; a += (p.ecnt_()[(layer * 32 + e) * 64] + 255) >> 8; } pblk[32] = a; }
    __syncthreads();
}

struct MoeCv { const float* cp; bf16_t* wt; int ldw, krows; };
__device__ __forceinline__ MoeCv moe_cv_desc(const Params& p, const int layer, const int it) {
    MoeCv d; const int tid = otid(), nl = tid & 63, kr = tid >> 6;
    if (it < 4096) {
        const int e = it >> 7, r = it & 127, nb = r >> 3, kb = r & 7, n = nb * 64 + nl;
        const float* w = (((n >> 4) & 1) ? p.moe_w3 : p.moe_w1) + ((size_t)layer * 32 + e) * 1024 * 512;
        d.ldw = 512; d.krows = 1024;
        d.cp = w + (n >> 5) * 16 + (n & 15) + (size_t)(kb * 128 + kr) * 512;
        d.wt = p.w13_t_() + (size_t)e * 1024 * 1024 + (size_t)(nb * 64) * 1024 + kb * 128;
    } else {
        const int j = it - 4096, e = j >> 6, r = j & 63, nb = r >> 2, kb = r & 3, n = nb * 64 + nl;
        d.ldw = 1024; d.krows = 512;
        d.cp = p.moe_w2 + ((size_t)layer * 32 + e) * 512 * 1024 + n + (size_t)(kb * 128 + kr) * 1024;
        d.wt = p.w2_t_() + (size_t)e * 1024 * 512 + (size_t)(nb * 64) * 512 + kb * 128;
    }
    return d;
}
__device__ __forceinline__ void moe_cv_load(const MoeCv& d, float (&vv)[32]) {
#pragma unroll
    for (int q = 0; q < 32; ++q) vv[q] = __builtin_nontemporal_load(d.cp + (size_t)(q * 4) * d.ldw);
}
__device__ __forceinline__ void moe_cv_store(const MoeCv& d, const float (&vv)[32], char* smem) {
    const int tid = otid(), nl = tid & 63, kr = tid >> 6;
    __syncthreads();
#pragma unroll
    for (int q = 0; q < 32; ++q) *(bf16_t*)(smem + nl * CT_STRIDE + (q * 4 + kr) * 2) = f2bf(vv[q]);
    __syncthreads();
#pragma unroll
    for (int i = 0; i < 4; ++i) {
        const int pid = i * 256 + tid, row = pid >> 4, c = pid & 15;
        *(u32x4*)(d.wt + (size_t)row * d.krows + c * 8) = *(const u32x4*)(smem + row * CT_STRIDE + c * 16);
    }
}
__device__ __forceinline__ void moe_conv_range(const Params& p, const int layer, int j, const int jend, const int step, char* smem) {
    float va[32], vb[32]; MoeCv da, db;
    if (j < jend) { da = moe_cv_desc(p, layer, j); moe_cv_load(da, va); }
#pragma unroll 1
    while (j < jend) {
        int jn = j + step;
        if (jn < jend) { db = moe_cv_desc(p, layer, jn); moe_cv_load(db, vb); }
        moe_cv_store(da, va, smem);
        j = jn; if (j >= jend) break;
        jn = j + step;
        if (jn < jend) { da = moe_cv_desc(p, layer, jn); moe_cv_load(da, va); }
        moe_cv_store(db, vb, smem);
        j = jn;
    }
}

__device__ __forceinline__ void moe_conv_item(const Params& p, const int layer, const int it, char* smem) {
    if (it < 4096) {
        const int j = it, e = j >> 7, r = j & 127, nb = r >> 3, kb = r & 7;
        const float* w1 = p.moe_w1 + ((size_t)layer * 32 + e) * 1024 * 512; const float* w3 = p.moe_w3 + ((size_t)layer * 32 + e) * 1024 * 512;
        conv_tile(nb * 64, kb * 128, 512, 1024, p.w13_t_() + (size_t)e * 1024 * 1024, nullptr,
                  [&](int n, const float*& cp, float& sc) { cp = (((n >> 4) & 1) ? w3 : w1) + (n >> 5) * 16 + (n & 15); sc = 1.0f; }, smem);
    } else {
        const int j = it - 4096, e = j >> 6, r = j & 63, nb = r >> 2, kb = r & 3;
        const float* w2 = p.moe_w2 + ((size_t)layer * 32 + e) * 512 * 1024;
        conv_tile(nb * 64, kb * 128, 1024, 512, p.w2_t_() + (size_t)e * 1024 * 512, nullptr,
                  [&](int n, const float*& cp, float& sc) { cp = w2 + n; sc = 1.0f; }, smem);
    }
}

__device__ __forceinline__ void phase_norm1(const Params& p, const int layer, char* smem) {
    const int tid = otid(), wid = tid >> 6, lane = tid & 63;
    int* pblk = (int*)(smem + 64 * CT_STRIDE);
    if (layer > 0) expert_prefix(p, layer - 1, pblk);
    const bool fin = layer == DEPTH;
    const int ntok = fin ? TL : TT;
    const int n_norm = ntok / 16;
    const int n_c13 = 0, n_c2 = 0;
    bf16_t* H = p.R2_();
    const bf16_t* Y = (const bf16_t*)p.R3_();
    for (int it = VB; it < n_norm + n_c13 + n_c2; it += NVB) {
        if (it < n_norm) {
            const int tk0 = it * 16 + wid * 4;
            const float* mdp = layer > 0 ? mod_row(p, layer - 1, tk0) + 5120 : nullptr;
            const float* md = fin ? nullptr : mod_row(p, layer, tk0);
            f32x4 ga[4], sh[4], gt[4];
#pragma unroll
            for (int i = 0; i < 4; ++i) {
                const int c = i * 256 + lane * 4;
                if (fin) { ga[i] = *(const f32x4*)(p.g_final + c); sh[i] = (f32x4){0.f, 0.f, 0.f, 0.f}; }
                else { const f32x4 g = *(const f32x4*)(p.g_mix + layer * 1024 + c), sc = *(const f32x4*)(md + 1024 + c); sh[i] = *(const f32x4*)(md + c);
                       ga[i][0] = g[0] * (1.0f + sc[0]); ga[i][1] = g[1] * (1.0f + sc[1]); ga[i][2] = g[2] * (1.0f + sc[2]); ga[i][3] = g[3] * (1.0f + sc[3]); }
                gt[i] = layer > 0 ? *(const f32x4*)(mdp + c) : (f32x4){0.f, 0.f, 0.f, 0.f};
            }
            bf16_t* XB = p.XB_();
            auto tail = [&](int tk, const f32x4 (&vq)[4]) {
                float ss = 0.f;
#pragma unroll
                for (int i = 0; i < 4; ++i) ss += vq[i][0] * vq[i][0] + vq[i][1] * vq[i][1] + vq[i][2] * vq[i][2] + vq[i][3] * vq[i][3];
                ss = wave_sum(ss);
                const float rstd = rsqrtf(ss * (1.0f / 1024.0f) + 1e-6f);
#pragma unroll
                for (int i = 0; i < 4; ++i) {
                    const int c = i * 256 + lane * 4;
                    float o[4];
#pragma unroll
                    for (int j = 0; j < 4; ++j) o[j] = vq[i][j] * rstd * ga[i][j] + sh[i][j];
                    if (fin) *(f32x4*)(p.out + (size_t)tk * 1024 + c) = (f32x4){o[0], o[1], o[2], o[3]};
                    else { u32x2 w; w.x = pk2(o[0], o[1]); w.y = pk2(o[2], o[3]); *(u32x2*)(H + (size_t)tk * 1024 + c) = w; }
                }
            };
            int ngrp = 1; asm volatile("" : "+s"(ngrp));
#pragma unroll 1
            for (int grp = 0; grp < ngrp; ++grp)
            if (layer == 0) {
                f32x4 v[4][4];
#pragma unroll
                for (int q = 0; q < 4; ++q) {
                    const int tk = tk0 + q;
                    const float* xin = tk < TL ? p.x + (size_t)tk * 1024 : p.ctx + (size_t)(tk - TL) * 1024;
#pragma unroll
                    for (int i = 0; i < 4; ++i) v[q][i] = __builtin_nontemporal_load((const f32x4*)(xin + i * 256 + lane * 4));
                }
#pragma unroll
                for (int q = 0; q < 4; ++q) tail(tk0 + q, v[q]);
            } else {
                u32x2 xb[4][4], y0[4][4], y1[4][4]; float g0[4], g1[4];
#pragma unroll
                for (int q = 0; q < 4; ++q) {
                    const int tk = tk0 + q;
#pragma unroll
                    for (int i = 0; i < 4; ++i) xb[q][i] = __builtin_nontemporal_load((const u32x2*)(XB + (size_t)tk * 1024 + i * 256 + lane * 4));
                    const int e0 = p.route_e_()[tk * 2], e1 = p.route_e_()[tk * 2 + 1];
                    const size_t s0 = (size_t)pblk[e0] * 256 + p.route_p_()[tk * 2], s1 = (size_t)pblk[e1] * 256 + p.route_p_()[tk * 2 + 1];
                    g0[q] = p.route_g_()[tk * 2]; g1[q] = p.route_g_()[tk * 2 + 1];
#pragma unroll
                    for (int i = 0; i < 4; ++i) { y0[q][i] = __builtin_nontemporal_load((const u32x2*)(Y + s0 * 1024 + i * 256 + lane * 4)); y1[q][i] = __builtin_nontemporal_load((const u32x2*)(Y + s1 * 1024 + i * 256 + lane * 4)); }
                }
#pragma unroll
                for (int q = 0; q < 4; ++q) {
                    const int tk = tk0 + q;
                    f32x4 vq[4];
#pragma unroll
                    for (int i = 0; i < 4; ++i) {
                        vq[i][0] = lo2f(xb[q][i].x) + gt[i][0] * (g0[q] * lo2f(y0[q][i].x) + g1[q] * lo2f(y1[q][i].x));
                        vq[i][1] = hi2f(xb[q][i].x) + gt[i][1] * (g0[q] * hi2f(y0[q][i].x) + g1[q] * hi2f(y1[q][i].x));
                        vq[i][2] = lo2f(xb[q][i].y) + gt[i][2] * (g0[q] * lo2f(y0[q][i].y) + g1[q] * lo2f(y1[q][i].y));
                        vq[i][3] = hi2f(xb[q][i].y) + gt[i][3] * (g0[q] * hi2f(y0[q][i].y) + g1[q] * hi2f(y1[q][i].y));
                        if (!fin) { u32x2 w; w.x = pk2(vq[i][0], vq[i][1]); w.y = pk2(vq[i][2], vq[i][3]); __builtin_nontemporal_store(w, (u32x2*)(XB + (size_t)tk * 1024 + i * 256 + lane * 4)); }
                    }
                    tail(tk, vq);
                }
            }
        } else if (it < n_norm + n_c13) {
            const int j = it - n_norm, e = j >> 7, r = j & 127, nb = r >> 3, kb = r & 7;
            const float* w1 = p.moe_w1 + ((size_t)layer * 32 + e) * 1024 * 512; const float* w3 = p.moe_w3 + ((size_t)layer * 32 + e) * 1024 * 512;
            conv_tile(nb * 64, kb * 128, 512, 1024, p.w13_t_() + (size_t)e * 1024 * 1024, nullptr,
                      [&](int n, const float*& cp, float& sc) { cp = (((n >> 4) & 1) ? w3 : w1) + (n >> 5) * 16 + (n & 15); sc = 1.0f; }, smem);
        } else {
            const int j = it - n_norm - n_c13, e = j >> 6, r = j & 63, nb = r >> 2, kb = r & 3;
            const float* w2 = p.moe_w2 + ((size_t)layer * 32 + e) * 512 * 1024;
            conv_tile(nb * 64, kb * 128, 1024, 512, p.w2_t_() + (size_t)e * 1024 * 512, nullptr,
                      [&](int n, const float*& cp, float& sc) { cp = w2 + n; sc = 1.0f; }, smem);
        }
    }
}

__device__ __forceinline__ void rope4(f32x4& v, const float* tab, int pi0) {
    const float c0 = tab[pi0 * 2], s0 = tab[pi0 * 2 + 1], c1 = tab[pi0 * 2 + 2], s1 = tab[pi0 * 2 + 3];
    const float a = v[0] * c0 - v[1] * s0, b = v[1] * c0 + v[0] * s0, c = v[2] * c1 - v[3] * s1, d = v[3] * c1 + v[2] * s1;
    v[0] = a; v[1] = b; v[2] = c; v[3] = d;
}
#define EPI_LOOP_T(...) _Pragma("unroll") for (int m_ = 0; m_ < 4; ++m_) _Pragma("unroll") for (int n_ = 0; n_ < 4; ++n_) { \
    const int row = wr * 64 + m_ * 16 + fr, col = wc * 64 + n_ * 16 + fq * 4; f32x4 v = acc[m_][n_]; __VA_ARGS__ }
#define GEMM_IDS const int tid = otid(), wid = tid >> 6, lane = tid & 63, wr = wid >> 1, wc = wid & 1, fr = lane & 15, fq = lane >> 4; (void)tid; (void)wid; (void)lane;

__device__ __forceinline__ void rope4_hw(f32x4& v, int t, int pi0, int F) {
    const float pos = (float)(pi0 < F ? (t >> 6) : (t & 63));
    const int f0 = pi0 & (F - 1);
    const float k = -13.287712379549449f / (float)F;
    const float x0 = pos * __builtin_amdgcn_exp2f(k * (float)f0) * 0.15915494309189535f, x1 = pos * __builtin_amdgcn_exp2f(k * (float)(f0 + 1)) * 0.15915494309189535f;
    const float c0 = __builtin_amdgcn_cosf(x0), s0 = __builtin_amdgcn_sinf(x0), c1 = __builtin_amdgcn_cosf(x1), s1 = __builtin_amdgcn_sinf(x1);
    const float a = v[0] * c0 - v[1] * s0, b = v[1] * c0 + v[0] * s0, c = v[2] * c1 - v[3] * s1, d = v[3] * c1 + v[2] * s1;
    v[0] = a; v[1] = b; v[2] = c; v[3] = d;
}
__device__ __forceinline__ void phase_win(const Params& p, const int layer, LAS unsigned char* lds, char* smh) {
    const bf16_t* H = p.R2_(); bf16_t* P = p.R1_(); bf16_t* VT = (bf16_t*)(p.R3_() + R3_NAVT);
    g8::StaticOrder S; S.init(TT, WIN_N, gridDim.x, blockIdx.x);
    g8::gemm8(lds, H, p.win_t_() + (size_t)layer * WIN_N * 1024, 1024, S,
        [&](const g8::Unit& u, int row) { return (unsigned)((u.pm * 256 + row) * 2048); },
        [&](const g8::Unit& u) { return (size_t)u.pn * 256 * 2048; },
        [&](const f32x4 (&acc)[2][2][4][2], const g8::Unit& u, int wr, int wc, int fr, int fq) {
            const bool lat = u.pm < TL / 256;
            const int tk0 = u.pm * 256 + wr * 64 + fr;
#pragma unroll
            for (int bj = 0; bj < 2; ++bj) {
                const int cg = __builtin_amdgcn_readfirstlane(u.pn * 256 + bj * 128 + wc * 32);
                if (cg >= PLD) continue;
                if (cg >= PC_NAV && cg < PC_U) {
#pragma unroll
                    for (int ai = 0; ai < 2; ++ai)
#pragma unroll
                        for (int m = 0; m < 4; ++m) {
                            const int tk = tk0 + ai * 128 + m * 16;
                            const int b = lat ? tk >> 11 : (tk - TL) >> 8, sq = lat ? tk & 2047 : SEQ + ((tk - TL) & 255);
#pragma unroll
                            for (int n = 0; n < 2; ++n) {
                                const f32x4 v = acc[ai][bj][m][n];
                                bf16_t* dst = VT + ((size_t)b * 256 + (cg - PC_NAV) + n * 16 + fq * 4) * SEQA + sq;
                                dst[0] = f2bf(v[0]); dst[SEQA] = f2bf(v[1]); dst[2 * SEQA] = f2bf(v[2]); dst[3 * SEQA] = f2bf(v[3]);
                            }
                        }
                } else if (lat && (cg == PC_KR || (cg >= PC_RQ && cg < PC_RV))) {
                    const bool rm = cg == PC_KR;
#pragma unroll
                    for (int ai = 0; ai < 2; ++ai)
#pragma unroll
                        for (int m = 0; m < 4; ++m) {
                            const int tk = tk0 + ai * 128 + m * 16, t = tk & 2047;
                            char* prow = (char*)(P + (size_t)tk * PLD + cg + fq * 4);
#pragma unroll
                            for (int n = 0; n < 2; ++n) {
                                f32x4 v = acc[ai][bj][m][n];
                                const int col = cg + n * 16 + fq * 4;
                                if (rm) rope4_hw(v, t, (col - PC_KR) >> 1, 8); else rope4_hw(v, t, ((col - PC_RQ) & 63) >> 1, 16);
                                u32x2 w; w.x = pk2(v[0], v[1]); w.y = pk2(v[2], v[3]);
                                *(u32x2*)(prow + n * 32) = w;
                            }
                        }
                } else if (cg >= PC_U && cg < PC_RQ) {
                    bf16_t* UG = p.UG_() + ((size_t)((cg - PC_U) >> 4) * TT) * 16 + fq * 4;
#pragma unroll
                    for (int ai = 0; ai < 2; ++ai)
#pragma unroll
                        for (int m = 0; m < 4; ++m) {
                            const int tk = tk0 + ai * 128 + m * 16;
                            char* prow = (char*)(P + (size_t)tk * PLD + cg + fq * 4);
#pragma unroll
                            for (int n = 0; n < 2; ++n) {
                                const f32x4 v = acc[ai][bj][m][n];
                                u32x2 w; w.x = pk2(v[0], v[1]); w.y = pk2(v[2], v[3]);
                                *(u32x2*)(prow + n * 32) = w;
                                *(u32x2*)(UG + ((size_t)n * TT + tk) * 16) = w;
                            }
                        }
                } else {
#pragma unroll
                    for (int ai = 0; ai < 2; ++ai)
#pragma unroll
                        for (int m = 0; m < 4; ++m) {
                            char* prow = (char*)(P + (size_t)(tk0 + ai * 128 + m * 16) * PLD + cg + fq * 4);
#pragma unroll
                            for (int n = 0; n < 2; ++n) {
                                const f32x4 v = acc[ai][bj][m][n];
                                u32x2 w; w.x = pk2(v[0], v[1]); w.y = pk2(v[2], v[3]);
                                *(u32x2*)(prow + n * 32) = w;
                            }
                        }
                }
            }
        });
    {
        const int nwg = (TT / 256) * (WIN_N / 256), rem = nwg % (int)gridDim.x;
        const int first = rem, nidle = (int)gridDim.x - rem;
        asm volatile("s_waitcnt vmcnt(0) lgkmcnt(0)" ::: "memory");
        if ((int)blockIdx.x >= first) {
            const int vb = ((int)blockIdx.x - first) * 2 + (rtid() >> 8), nvb = nidle * 2;
            moe_conv_range(p, layer, vb, 4096, nvb, smh);
        }
    }
}

#define RT_KS_STRIDE 144
#define RT_KT_STRIDE 272
#define RT_KT_OFF (128 * RT_KS_STRIDE)
#define RT_VT_OFF (RT_KT_OFF + 64 * RT_KT_STRIDE)
#define RT_LDS_BYTES (RT_VT_OFF + 64 * RT_KT_STRIDE)
__device__ __forceinline__ int ret_tok0(int b, int c) { return c < 16 ? b * SEQ + c * 128 : TL + b * CTXL + (c - 16) * 128; }
__device__ __forceinline__ void ret_pass1_item(const Params& p, int layer, int item, char* smem) {
    const int tid = otid(), wid = tid >> 6, lane = tid & 63, r = lane & 31, h2 = lane >> 5;
    const bf16_t* P = p.R1_();
    float* YI = (float*)(p.R3_() + R3_RETYI); float* RS = (float*)(p.R3_() + R3_RETRS);
    char* KS = smem; char* KT = smem + RT_KT_OFF; char* VT = smem + RT_VT_OFF;
    const int h = item & 3, bc = item >> 2, b = bc / 18, c = bc % 18;
    const int tok0 = ret_tok0(b, c);
    const float lgf = p.ret_log_decay[(layer * 2 + 0) * 4 + h] * 1.4426950408889634f, lgb = p.ret_log_decay[(layer * 2 + 1) * 4 + h] * 1.4426950408889634f;
    __syncthreads();
#pragma unroll
    for (int i = 0; i < 4; ++i) {
        const int piece = i * 256 + tid, c8 = piece >> 7, key = piece & 127;
        union { u32x4 v; bf16_t e[8]; } wk, wv;
        wk.v = *(const u32x4*)(P + (size_t)(tok0 + key) * PLD + PC_RK + h * 64 + c8 * 8);
        wv.v = *(const u32x4*)(P + (size_t)(tok0 + key) * PLD + PC_RV + h * 64 + c8 * 8);
        *(u32x4*)(KS + key * RT_KS_STRIDE + c8 * 16) = wk.v;
#pragma unroll
        for (int j = 0; j < 8; ++j) {
            *(bf16_t*)(KT + (c8 * 8 + j) * RT_KT_STRIDE + key * 2) = wk.e[j];
            *(bf16_t*)(VT + (c8 * 8 + j) * RT_KT_STRIDE + key * 2) = wv.e[j];
        }
    }
    __syncthreads();
    const int t = wid * 32 + r;
    const int tkq = tok0 + t;
    bf16x8 qf[4];
#pragma unroll
    for (int ks = 0; ks < 4; ++ks) qf[ks] = *(const bf16x8*)(P + (size_t)tkq * PLD + PC_RQ + h * 64 + 16 * ks + 8 * h2);
    f32x16 o0, o1;
#pragma unroll
    for (int i = 0; i < 16; ++i) { o0[i] = 0.f; o1[i] = 0.f; }
#pragma unroll 1
    for (int kt4 = 0; kt4 < 4; ++kt4) {
        f32x16 sc;
#pragma unroll
        for (int i = 0; i < 16; ++i) sc[i] = 0.f;
#pragma unroll
        for (int ks = 0; ks < 4; ++ks) {
            const bf16x8 a = *(const bf16x8*)(KS + (kt4 * 32 + r) * RT_KS_STRIDE + (16 * ks + 8 * h2) * 2);
            sc = __builtin_amdgcn_mfma_f32_32x32x16_bf16(a, qf[ks], sc, 0, 0, 0);
        }
#pragma unroll
        for (int i = 0; i < 16; ++i) {
            const int sidx = kt4 * 32 + (i & 3) + 8 * (i >> 2) + 4 * h2, n = t - sidx;
            sc[i] *= n >= 0 ? __builtin_amdgcn_exp2f(lgf * (float)n) : __builtin_amdgcn_exp2f(lgb * (float)(-n));
        }
#pragma unroll
        for (int s2 = 0; s2 < 2; ++s2) {
            union { bf16x8 v; unsigned u[4]; } pb, a0, a1;
#pragma unroll
            for (int j = 0; j < 4; ++j) pb.u[j] = pk2(sc[8 * s2 + 2 * j], sc[8 * s2 + 2 * j + 1]);
            const int kb = (kt4 * 32 + 16 * s2 + 4 * h2) * 2;
            const u32x2 x0 = *(const u32x2*)(VT + r * RT_KT_STRIDE + kb), x1 = *(const u32x2*)(VT + r * RT_KT_STRIDE + kb + 16);
            const u32x2 y0 = *(const u32x2*)(VT + (32 + r) * RT_KT_STRIDE + kb), y1 = *(const u32x2*)(VT + (32 + r) * RT_KT_STRIDE + kb + 16);
            a0.u[0] = x0.x; a0.u[1] = x0.y; a0.u[2] = x1.x; a0.u[3] = x1.y;
            a1.u[0] = y0.x; a1.u[1] = y0.y; a1.u[2] = y1.x; a1.u[3] = y1.y;
            o0 = __builtin_amdgcn_mfma_f32_32x32x16_bf16(a0.v, pb.v, o0, 0, 0, 0);
            o1 = __builtin_amdgcn_mfma_f32_32x32x16_bf16(a1.v, pb.v, o1, 0, 0, 0);
        }
    }
#pragma unroll
    for (int g4 = 0; g4 < 4; ++g4) {
        *(f32x4*)(YI + (size_t)tkq * 256 + h * 64 + 8 * g4 + 4 * h2) = (f32x4){o0[4 * g4], o0[4 * g4 + 1], o0[4 * g4 + 2], o0[4 * g4 + 3]};
        *(f32x4*)(YI + (size_t)tkq * 256 + h * 64 + 32 + 8 * g4 + 4 * h2) = (f32x4){o1[4 * g4], o1[4 * g4 + 1], o1[4 * g4 + 2], o1[4 * g4 + 3]};
    }
    const int dir = wid & 1, et = wid >> 1;
    f32x16 st0, st1;
#pragma unroll
    for (int i = 0; i < 16; ++i) { st0[i] = 0.f; st1[i] = 0.f; }
#pragma unroll 1
    for (int ks = 0; ks < 8; ++ks) {
        union { bf16x8 v; unsigned u[4]; } a;
        a.v = *(const bf16x8*)(VT + (et * 32 + r) * RT_KT_STRIDE + (16 * ks + 8 * h2) * 2);
#pragma unroll
        for (int j = 0; j < 4; ++j) {
            const int s0i = 16 * ks + 8 * h2 + 2 * j;
            const float w0 = dir == 0 ? __builtin_amdgcn_exp2f(lgf * (float)(127 - s0i)) : __builtin_amdgcn_exp2f(lgb * (float)s0i);
            const float w1 = dir == 0 ? __builtin_amdgcn_exp2f(lgf * (float)(126 - s0i)) : __builtin_amdgcn_exp2f(lgb * (float)(s0i + 1));
            a.u[j] = pk2(lo2f(a.u[j]) * w0, hi2f(a.u[j]) * w1);
        }
        const bf16x8 b0 = *(const bf16x8*)(KT + r * RT_KT_STRIDE + (16 * ks + 8 * h2) * 2);
        const bf16x8 b1 = *(const bf16x8*)(KT + (32 + r) * RT_KT_STRIDE + (16 * ks + 8 * h2) * 2);
        st0 = __builtin_amdgcn_mfma_f32_32x32x16_bf16(a.v, b0, st0, 0, 0, 0);
        st1 = __builtin_amdgcn_mfma_f32_32x32x16_bf16(a.v, b1, st1, 0, 0, 0);
    }
    float* rs = RS + ((size_t)item * 2 + dir) * 4096;
#pragma unroll
    for (int i = 0; i < 16; ++i) {
        const int e = et * 32 + (i & 3) + 8 * (i >> 2) + 4 * h2;
        rs[e * 64 + r] = st0[i]; rs[e * 64 + 32 + r] = st1[i];
    }
}
__device__ __forceinline__ void ret_carry_item(const Params& p, int layer, int item) {
    const int sub = item & 15, dir = (item >> 4) & 1, h = (item >> 5) & 3, b = item >> 7;
    const int el = sub * 256 + otid();
    const float* RS = (const float*)(p.R3_() + R3_RETRS); bf16_t* RIN = (bf16_t*)(p.R3_() + R3_RETRIN);
    const float g128 = exp2f(p.ret_log_decay[(layer * 2 + dir) * 4 + h] * 1.4426950408889634f * 128.0f);
    float v[18];
#pragma unroll
    for (int i = 0; i < 18; ++i) {
        const int k = dir == 0 ? (i < 2 ? 16 + i : i - 2) : 17 - i;
        v[i] = __builtin_nontemporal_load(RS + ((((size_t)b * 18 + k) * 4 + h) * 2 + dir) * 4096 + el);
    }
    float st = 0.f;
#pragma unroll
    for (int i = 0; i < 18; ++i) {
        const int k = dir == 0 ? (i < 2 ? 16 + i : i - 2) : 17 - i;
        RIN[((((size_t)b * 18 + k) * 4 + h) * 2 + dir) * 4096 + el] = f2bf(st);
        st = st * g128 + v[i];
    }
}
__device__ __forceinline__ void ret_pass2_item(const Params& p, int layer, int item) {
    const int tid = otid(), wid = tid >> 6, lane = tid & 63, r = lane & 31, h2 = lane >> 5;
    const bf16_t* P = p.R1_(); bf16_t* MIX = p.R2_();
    const float* YI = (const float*)(p.R3_() + R3_RETYI); const bf16_t* RIN = (const bf16_t*)(p.R3_() + R3_RETRIN);
    const int h = item & 3, bc = item >> 2, b = bc / 18, c = bc % 18;
    const int t = wid * 32 + r, tkq = ret_tok0(b, c) + t;
    const float lgf = p.ret_log_decay[(layer * 2 + 0) * 4 + h] * 1.4426950408889634f, lgb = p.ret_log_decay[(layer * 2 + 1) * 4 + h] * 1.4426950408889634f;
    bf16x8 qf[4];
#pragma unroll
    for (int ks = 0; ks < 4; ++ks) qf[ks] = *(const bf16x8*)(P + (size_t)tkq * PLD + PC_RQ + h * 64 + 16 * ks + 8 * h2);
    f32x16 y0, y1;
#pragma unroll
    for (int g4 = 0; g4 < 4; ++g4) {
        const f32x4 a = __builtin_nontemporal_load((const f32x4*)(YI + (size_t)tkq * 256 + h * 64 + 8 * g4 + 4 * h2)), bq = __builtin_nontemporal_load((const f32x4*)(YI + (size_t)tkq * 256 + h * 64 + 32 + 8 * g4 + 4 * h2));
#pragma unroll
        for (int q = 0; q < 4; ++q) { y0[4 * g4 + q] = a[q]; y1[4 * g4 + q] = bq[q]; }
    }
#pragma unroll
    for (int dir = 0; dir < 2; ++dir) {
        const bf16_t* R = RIN + ((size_t)item * 2 + dir) * 4096;
        f32x16 x0, x1;
#pragma unroll
        for (int i = 0; i < 16; ++i) { x0[i] = 0.f; x1[i] = 0.f; }
#pragma unroll
        for (int ks = 0; ks < 4; ++ks) {
            const bf16x8 a0 = *(const bf16x8*)(R + r * 64 + 16 * ks + 8 * h2), a1 = *(const bf16x8*)(R + (32 + r) * 64 + 16 * ks + 8 * h2);
            x0 = __builtin_amdgcn_mfma_f32_32x32x16_bf16(a0, qf[ks], x0, 0, 0, 0);
            x1 = __builtin_amdgcn_mfma_f32_32x32x16_bf16(a1, qf[ks], x1, 0, 0, 0);
        }
        const float sc = dir == 0 ? __builtin_amdgcn_exp2f(lgf * (float)(t + 1)) : __builtin_amdgcn_exp2f(lgb * (float)(128 - t));
#pragma unroll
        for (int i = 0; i < 16; ++i) { y0[i] += sc * x0[i]; y1[i] += sc * x1[i]; }
    }
    float sm = 0.f;
#pragma unroll
    for (int i = 0; i < 16; ++i) sm += y0[i] + y1[i];
    sm = xh32_sum(sm);
    const float mu = sm * (1.0f / 64.0f);
    float vr = 0.f;
#pragma unroll
    for (int i = 0; i < 16; ++i) { y0[i] -= mu; y1[i] -= mu; vr += y0[i] * y0[i] + y1[i] * y1[i]; }
    vr = xh32_sum(vr);
    const float rs = rsqrtf(vr * (1.0f / 64.0f) + 1e-6f);
#pragma unroll
    for (int g4 = 0; g4 < 4; ++g4) {
        const int e0 = h * 64 + 8 * g4 + 4 * h2;
        const u32x2 ga = *(const u32x2*)(P + (size_t)tkq * PLD + PC_RG + e0), gb = *(const u32x2*)(P + (size_t)tkq * PLD + PC_RG + 32 + e0);
        u32x2 w0, w1;
        w0.x = pk2(silu_f(lo2f(ga.x)) * y0[4 * g4] * rs, silu_f(hi2f(ga.x)) * y0[4 * g4 + 1] * rs);
        w0.y = pk2(silu_f(lo2f(ga.y)) * y0[4 * g4 + 2] * rs, silu_f(hi2f(ga.y)) * y0[4 * g4 + 3] * rs);
        w1.x = pk2(silu_f(lo2f(gb.x)) * y1[4 * g4] * rs, silu_f(hi2f(gb.x)) * y1[4 * g4 + 1] * rs);
        w1.y = pk2(silu_f(lo2f(gb.y)) * y1[4 * g4 + 2] * rs, silu_f(hi2f(gb.y)) * y1[4 * g4 + 3] * rs);
        *(u32x2*)(MIX + (size_t)tkq * 1024 + 768 + e0) = w0;
        *(u32x2*)(MIX + (size_t)tkq * 1024 + 768 + 32 + e0) = w1;
    }
}

__device__ __forceinline__ int s5_tokbase(int R) {
    const int b = R / S5NCH, ch = R % S5NCH;
    return ch < 64 ? b * SEQ + ch * S5CH : TL + b * CTXL + (ch - 64) * S5CH;
}
__device__ __forceinline__ void phase_up(const Params& p, const int layer, char* smem) {
    GEMM_IDS
    const bf16_t* P = p.R1_();
    bf16_t* Q = (bf16_t*)(p.R3_() + R3_MLAQ); bf16_t* Kn = (bf16_t*)(p.R3_() + R3_MLAK); bf16_t* Vv = (bf16_t*)(p.R3_() + R3_MLAV);
    float* Sloc = (float*)(p.R3_() + R3_S5SLOC);
    const bf16_t* Wq = p.wuq_t_() + (size_t)layer * 384 * 192;
    const bf16_t* Wkv = p.wukv_t_() + (size_t)layer * 512 * 128;
    const int nq = 576 * 3, nk = 576 * 2, nv = 576 * 2, ns5 = 16 * 18 * 2, nret = BATCH * 18 * 4;
    for (int it = VBX; it < nq + nk + nv + ns5 + nret; it += NVB) {
        const int it2 = it < nret ? (nq + nk + nv + ns5) + it : (it - nret < ns5 ? (nq + nk + nv) + (it - nret) : it - nret - ns5);
        f32x4 acc[4][4];
        if (it2 >= nq + nk + nv + ns5) { ret_pass1_item(p, layer, it2 - (nq + nk + nv + ns5), smem); __syncthreads(); }
        else if (it2 < nq) {
            const int mt = it2 / 3, nt = it2 % 3;
            gemm128<true, true>([&](int r, int k) { return P + (size_t)(mt * 128 + r) * PLD + PC_CQ + k; },
                                [&](int r, int k) { return Wq + (size_t)(nt * 128 + r) * 192 + k; }, 192, acc, smem);
            const float* SS = GEMM_SS(smem);
            EPI_LOOP_T({
                const int tk = mt * 128 + row, n = nt * 128 + col;
                const float rstd = rsqrtf(SS[row] * (1.0f / 192.0f) + 1e-6f);
                v *= rstd;
                const int j = n % 96;
                if (tk < TL && j >= 64) rope4(v, p.ropeM_() + (tk & 2047) * 32, (j - 64) >> 1);
                u32x2 w; w.x = pk2(v[0], v[1]); w.y = pk2(v[2], v[3]);
                *(u32x2*)(Q + (size_t)tk * 384 + n) = w;
            })
        } else if (it2 < nq + nk) {
            const int j = it2 - nq, mt = j >> 1, nt = j & 1;
            gemm128<true, true>([&](int r, int k) { return P + (size_t)(mt * 128 + r) * PLD + PC_CKV + k; },
                                [&](int r, int k) { return Wkv + (size_t)(nt * 128 + r) * 128 + k; }, 128, acc, smem);
            const float* SS = GEMM_SS(smem);
            bf16_t* O = Kn;
            EPI_LOOP_T({
                const int tk = mt * 128 + row, n = (nt & 1) * 128 + col;
                const float rstd = rsqrtf(SS[row] * (1.0f / 128.0f) + 1e-6f);
                u32x2 w; w.x = pk2(v[0] * rstd, v[1] * rstd); w.y = pk2(v[2] * rstd, v[3] * rstd);
                *(u32x2*)(O + (size_t)tk * 256 + n) = w;
            })
        } else if (it2 < nq + nk + nv) {
            const int j = it2 - nq - nk, mt = j >> 1, nt = j & 1;
            gemm128<false, true>([&](int r, int k) { return P + (size_t)(mt * 128 + r) * PLD + PC_CKV + k; },
                                 [&](int r, int k) { return Wkv + (size_t)(256 + nt * 128 + r) * 128 + k; }, 128, acc, smem);
            const float* SS = GEMM_SS(smem);
#pragma unroll
            for (int m_ = 0; m_ < 4; ++m_)
#pragma unroll
                for (int n_ = 0; n_ < 4; ++n_) {
                    const int row = wr * 64 + m_ * 16 + fq * 4, col = wc * 64 + n_ * 16 + fr;
                    const int tk = mt * 128 + row, n = nt * 128 + col;
                    const int b = tk < TL ? tk >> 11 : (tk - TL) >> 8, sq = tk < TL ? tk & 2047 : SEQ + ((tk - TL) & 255);
                    const f32x4 v = acc[m_][n_];
                    u32x2 w;
                    w.x = pk2(v[0] * rsqrtf(SS[row] * (1.0f / 128.0f) + 1e-6f), v[1] * rsqrtf(SS[row + 1] * (1.0f / 128.0f) + 1e-6f));
                    w.y = pk2(v[2] * rsqrtf(SS[row + 2] * (1.0f / 128.0f) + 1e-6f), v[3] * rsqrtf(SS[row + 3] * (1.0f / 128.0f) + 1e-6f));
                    *(u32x2*)(Vv + ((size_t)b * 256 + n) * SEQA + sq) = w;
                }
            __syncthreads();
        } else {
            const int j = it2 - nq - nk - nv, g = j / 36, r2 = j % 36, mt = r2 >> 1, nt = r2 & 1;
            const bf16_t* Ws = p.s5ws_() + ((size_t)(layer * 16 + g) * 256) * 512;
            const int tb0 = s5_tokbase(mt * 128 + (tid >> 2)), tb1 = s5_tokbase(mt * 128 + 64 + (tid >> 2));
            const bf16_t* UGg = p.UG_() + (size_t)g * TT * 16;
            gemm128<true, false>([&](int r, int k) { return UGg + (size_t)(r < 64 ? tb0 : tb1) * 16 + k; },
                                 [&](int r, int k) { return Ws + (size_t)(nt * 128 + r) * 512 + k; }, 512, acc, smem);
            EPI_LOOP_T({
                const int R = mt * 128 + row, n = nt * 128 + col;
                *(f32x4*)(Sloc + ((size_t)R * 16 + g) * 256 + n) = v;
            })
        }
    }
}

__device__ __forceinline__ void load_row_bf16_64(const bf16_t* ptr, float (&o)[64]) {
#pragma unroll
    for (int i = 0; i < 8; ++i) { const u32x4 w = *(const u32x4*)(ptr + i * 8);
        o[i * 8 + 0] = lo2f(w.x); o[i * 8 + 1] = hi2f(w.x); o[i * 8 + 2] = lo2f(w.y); o[i * 8 + 3] = hi2f(w.y);
        o[i * 8 + 4] = lo2f(w.z); o[i * 8 + 5] = hi2f(w.z); o[i * 8 + 6] = lo2f(w.w); o[i * 8 + 7] = hi2f(w.w); }
}
__device__ __forceinline__ void load_row_bf16_32(const bf16_t* ptr, float (&o)[32]) {
#pragma unroll
    for (int i = 0; i < 4; ++i) { const u32x4 w = *(const u32x4*)(ptr + i * 8);
        o[i * 8 + 0] = lo2f(w.x); o[i * 8 + 1] = hi2f(w.x); o[i * 8 + 2] = lo2f(w.y); o[i * 8 + 3] = hi2f(w.y);
        o[i * 8 + 4] = lo2f(w.z); o[i * 8 + 5] = hi2f(w.z); o[i * 8 + 6] = lo2f(w.w); o[i * 8 + 7] = hi2f(w.w); }
}
__device__ __forceinline__ void store_row_bf16_64(bf16_t* ptr, const float (&o)[64]) {
#pragma unroll
    for (int i = 0; i < 8; ++i) { u32x4 w; w.x = pk2(o[i * 8], o[i * 8 + 1]); w.y = pk2(o[i * 8 + 2], o[i * 8 + 3]); w.z = pk2(o[i * 8 + 4], o[i * 8 + 5]); w.w = pk2(o[i * 8 + 6], o[i * 8 + 7]);
        *(u32x4*)(ptr + i * 8) = w; }
}

template <int N> __device__ __forceinline__ float dot_row_bf16(const bf16_t* ptr, const float* q, float s) {
#pragma unroll
    for (int i = 0; i < N / 8; ++i) { const u32x4 w = *(const u32x4*)(ptr + i * 8);
        s += q[i * 8 + 0] * lo2f(w.x); s += q[i * 8 + 1] * hi2f(w.x); s += q[i * 8 + 2] * lo2f(w.y); s += q[i * 8 + 3] * hi2f(w.y);
        s += q[i * 8 + 4] * lo2f(w.z); s += q[i * 8 + 5] * hi2f(w.z); s += q[i * 8 + 6] * lo2f(w.w); s += q[i * 8 + 7] * hi2f(w.w); }
    return s;
}
__device__ __forceinline__ void axpy_row_bf16_64(const bf16_t* ptr, float* o, float al, float pe) {
#pragma unroll
    for (int i = 0; i < 8; ++i) { const u32x4 w = *(const u32x4*)(ptr + i * 8);
        o[i * 8 + 0] = o[i * 8 + 0] * al + pe * lo2f(w.x); o[i * 8 + 1] = o[i * 8 + 1] * al + pe * hi2f(w.x);
        o[i * 8 + 2] = o[i * 8 + 2] * al + pe * lo2f(w.y); o[i * 8 + 3] = o[i * 8 + 3] * al + pe * hi2f(w.y);
        o[i * 8 + 4] = o[i * 8 + 4] * al + pe * lo2f(w.z); o[i * 8 + 5] = o[i * 8 + 5] * al + pe * hi2f(w.z);
        o[i * 8 + 6] = o[i * 8 + 6] * al + pe * lo2f(w.w); o[i * 8 + 7] = o[i * 8 + 7] * al + pe * hi2f(w.w); }
}
__device__ __forceinline__ void axpy1_row_bf16_64(const bf16_t* ptr, float* o, float pe) {
#pragma unroll
    for (int i = 0; i < 8; ++i) { const u32x4 w = *(const u32x4*)(ptr + i * 8);
        o[i * 8 + 0] += pe * lo2f(w.x); o[i * 8 + 1] += pe * hi2f(w.x); o[i * 8 + 2] += pe * lo2f(w.y); o[i * 8 + 3] += pe * hi2f(w.y);
        o[i * 8 + 4] += pe * lo2f(w.z); o[i * 8 + 5] += pe * hi2f(w.z); o[i * 8 + 6] += pe * lo2f(w.w); o[i * 8 + 7] += pe * hi2f(w.w); }
}
__device__ __forceinline__ void mla_naive_item(const Params& p, int item, bool ctxq) {
    const int tid = otid();
    const bf16_t* P = p.R1_(); const bf16_t* Q = (const bf16_t*)(p.R3_() + R3_MLAQ); const bf16_t* Kn = (const bf16_t*)(p.R3_() + R3_MLAK); const bf16_t* Vv = (const bf16_t*)(p.R3_() + R3_MLAV);
    bf16_t* MIX = p.R2_();
    int b, h, tk, nkeys;
    if (!ctxq) { b = item >> 5; h = (item >> 3) & 3; tk = b * SEQ + (item & 7) * 256 + tid; nkeys = SEQA; }
    else { b = item >> 2; h = item & 3; tk = TL + b * CTXL + tid; nkeys = CTXL; }
    float qn[64], qr[32], o[64];
    load_row_bf16_64(Q + (size_t)tk * 384 + h * 96, qn);
    load_row_bf16_32(Q + (size_t)tk * 384 + h * 96 + 64, qr);
#pragma unroll
    for (int d = 0; d < 64; ++d) o[d] = 0.f;
    float m = -1e30f, l = 0.f;
    for (int kk = 0; kk < nkeys; ++kk) {
        const int kt = ctxq ? (TL + b * CTXL + kk) : (kk < SEQ ? b * SEQ + kk : TL + b * CTXL + (kk - SEQ));
        float s = dot_row_bf16<64>(Kn + (size_t)kt * 256 + h * 64, qn, 0.f);
        s = dot_row_bf16<32>(P + (size_t)kt * PLD + PC_KR, qr, s);
        const float mn = fmaxf(m, s), al = __expf(m - mn), pe = __expf(s - mn);
        l = l * al + pe; m = mn;
        axpy_row_bf16_64(Vv + (size_t)kt * 256 + h * 64, o, al, pe);
    }
    const float inv = 1.0f / l;
#pragma unroll
    for (int d = 0; d < 64; ++d) o[d] *= inv;
    store_row_bf16_64(MIX + (size_t)tk * 1024 + h * 64, o);
}

#define MLA_KS_STRIDE 208
#define MLA_VS_STRIDE 144
#define MLA_VS_OFF (64 * MLA_KS_STRIDE)
__device__ __forceinline__ void mla_item(const Params& p, int item, bool ctxq, char* smem) {
    const int tid = otid(), wid = tid >> 6, lane = tid & 63, r = lane & 31, h2 = lane >> 5;
    const bf16_t* P = p.R1_(); const bf16_t* Q = (const bf16_t*)(p.R3_() + R3_MLAQ); const bf16_t* Kn = (const bf16_t*)(p.R3_() + R3_MLAK); const bf16_t* VT = (const bf16_t*)(p.R3_() + R3_MLAV);
    bf16_t* MIX = p.R2_();
    char* KS = smem; char* VS = smem + MLA_VS_OFF;
    int b, h, tq0, kt0, nkt;
    if (!ctxq) { b = item >> 5; h = (item >> 3) & 3; tq0 = b * SEQ + (item & 7) * 256 + wid * 64 + r; kt0 = 0; nkt = 36; }
    else { b = item >> 2; h = item & 3; tq0 = TL + b * CTXL + wid * 64 + r; kt0 = 32; nkt = 4; }
    bf16x8 qf[2][6];
#pragma unroll
    for (int qt = 0; qt < 2; ++qt)
#pragma unroll
        for (int s = 0; s < 6; ++s) qf[qt][s] = *(const bf16x8*)(Q + (size_t)(tq0 + qt * 32) * 384 + h * 96 + 16 * s + 8 * h2);
    f32x16 o0[2], o1[2];
#pragma unroll
    for (int qt = 0; qt < 2; ++qt)
#pragma unroll
        for (int i = 0; i < 16; ++i) { o0[qt][i] = 0.f; o1[qt][i] = 0.f; }
    float m[2] = {0.f, 0.f}, l[2] = {0.f, 0.f};
    u32x4 pk[3], pv[2];
    const char* kp[3]; unsigned kstr[3], kdst[3]; const char* vp[2]; unsigned vdst[2];
#pragma unroll
    for (int i = 0; i < 3; ++i) {
        const int piece = tid + 256 * i, key = piece / 12, c = piece % 12;
        kp[i] = c < 8 ? (const char*)(Kn + (size_t)key * 256 + h * 64 + c * 8) : (const char*)(P + (size_t)key * PLD + PC_KR + (c - 8) * 8);
        kstr[i] = c < 8 ? 512u : (unsigned)(PLD * 2);
        kdst[i] = key * MLA_KS_STRIDE + c * 16;
    }
#pragma unroll
    for (int i = 0; i < 2; ++i) {
        const int piece = tid + 256 * i, d = piece >> 3, c = piece & 7;
        vp[i] = (const char*)(VT + ((size_t)b * 256 + h * 64 + d) * SEQA + c * 8);
        vdst[i] = d * MLA_VS_STRIDE + c * 16;
    }
    auto prefetch = [&](int kt) {
        const int seq0 = kt * 64;
        const unsigned tok0 = seq0 < SEQ ? b * SEQ + seq0 : TL + b * CTXL + (seq0 - SEQ);
#pragma unroll
        for (int i = 0; i < 3; ++i) pk[i] = *(const u32x4*)(kp[i] + (size_t)tok0 * kstr[i]);
#pragma unroll
        for (int i = 0; i < 2; ++i) pv[i] = *(const u32x4*)(vp[i] + seq0 * 2);
    };
    prefetch(kt0);
    const f32x16 zero16 = {0.f, 0.f, 0.f, 0.f, 0.f, 0.f, 0.f, 0.f, 0.f, 0.f, 0.f, 0.f, 0.f, 0.f, 0.f, 0.f};
    const char* KA0 = KS + r * MLA_KS_STRIDE + 16 * h2; const char* KA1 = KA0 + 32 * MLA_KS_STRIDE;
    const char* VA0 = VS + r * MLA_VS_STRIDE + 8 * h2; const char* VA1 = VA0 + 32 * MLA_VS_STRIDE;
    for (int kt = kt0; kt < kt0 + nkt; ++kt) {
        __syncthreads();
#pragma unroll
        for (int i = 0; i < 3; ++i) *(u32x4*)(KS + kdst[i]) = pk[i];
#pragma unroll
        for (int i = 0; i < 2; ++i) *(u32x4*)(VS + vdst[i]) = pv[i];
        __syncthreads();
        if (kt + 1 < kt0 + nkt) prefetch(kt + 1);
        if (kt == kt0) {
#pragma unroll
            for (int qt = 0; qt < 2; ++qt) {
                f32x16 s0 = __builtin_amdgcn_mfma_f32_32x32x16_bf16(*(const bf16x8*)(KA0), qf[qt][0], zero16, 0, 0, 0);
#pragma unroll
                for (int s = 1; s < 6; ++s) s0 = __builtin_amdgcn_mfma_f32_32x32x16_bf16(*(const bf16x8*)(KA0 + 32 * s), qf[qt][s], s0, 0, 0, 0);
                float mx = s0[0];
#pragma unroll
                for (int i = 1; i < 16; ++i) mx = fmaxf(mx, s0[i]);
                m[qt] = xh32_max(mx);
            }
        } else {
#pragma unroll
            for (int qt = 0; qt < 2; ++qt) {
                const bool big = l[qt] > 0x1p40f;
                if (__any(big)) {
                    const float al = big ? 0x1p-40f : 1.0f;
                    m[qt] += big ? 40.0f : 0.0f; l[qt] *= al;
#pragma unroll
                    for (int i = 0; i < 16; ++i) { o0[qt][i] *= al; o1[qt][i] *= al; }
                }
            }
        }
#pragma unroll
        for (int t = 0; t < 2; ++t) {
            const char* KA = t == 0 ? KA0 : KA1;
            f32x16 sc[2];
#pragma unroll
            for (int qt = 0; qt < 2; ++qt) {
                sc[qt] = __builtin_amdgcn_mfma_f32_32x32x16_bf16(*(const bf16x8*)(KA), qf[qt][0], zero16, 0, 0, 0);
#pragma unroll
                for (int s = 1; s < 6; ++s) sc[qt] = __builtin_amdgcn_mfma_f32_32x32x16_bf16(*(const bf16x8*)(KA + 32 * s), qf[qt][s], sc[qt], 0, 0, 0);
            }
#pragma unroll
            for (int qt = 0; qt < 2; ++qt) {
                float rs = 0.f;
#pragma unroll
                for (int i = 0; i < 16; ++i) { sc[qt][i] = __builtin_amdgcn_exp2f(sc[qt][i] - m[qt]); rs += sc[qt][i]; }
                l[qt] += xh32_sum(rs);
#pragma unroll
                for (int s = 0; s < 2; ++s) {
                    union { bf16x8 v; unsigned u[4]; } a0, a1, pb;
                    const int kb = (32 * t + 16 * s) * 2;
                    const u32x2 x0 = *(const u32x2*)(VA0 + kb), x1 = *(const u32x2*)(VA0 + kb + 16);
                    const u32x2 y0 = *(const u32x2*)(VA1 + kb), y1 = *(const u32x2*)(VA1 + kb + 16);
                    a0.u[0] = x0.x; a0.u[1] = x0.y; a0.u[2] = x1.x; a0.u[3] = x1.y;
                    a1.u[0] = y0.x; a1.u[1] = y0.y; a1.u[2] = y1.x; a1.u[3] = y1.y;
#pragma unroll
                    for (int j = 0; j < 4; ++j) pb.u[j] = pk2(sc[qt][8 * s + 2 * j], sc[qt][8 * s + 2 * j + 1]);
                    o0[qt] = __builtin_amdgcn_mfma_f32_32x32x16_bf16(a0.v, pb.v, o0[qt], 0, 0, 0);
                    o1[qt] = __builtin_amdgcn_mfma_f32_32x32x16_bf16(a1.v, pb.v, o1[qt], 0, 0, 0);
                }
            }
        }
    }
#pragma unroll
    for (int qt = 0; qt < 2; ++qt) {
        const float inv = 1.0f / l[qt];
        const size_t tkq = (size_t)(tq0 + qt * 32);
#pragma unroll
        for (int g4 = 0; g4 < 4; ++g4) {
            u32x2 w0, w1;
            w0.x = pk2(o0[qt][4 * g4] * inv, o0[qt][4 * g4 + 1] * inv); w0.y = pk2(o0[qt][4 * g4 + 2] * inv, o0[qt][4 * g4 + 3] * inv);
            w1.x = pk2(o1[qt][4 * g4] * inv, o1[qt][4 * g4 + 1] * inv); w1.y = pk2(o1[qt][4 * g4 + 2] * inv, o1[qt][4 * g4 + 3] * inv);
            *(u32x2*)(MIX + tkq * 1024 + h * 64 + 8 * g4 + 4 * h2) = w0;
            *(u32x2*)(MIX + tkq * 1024 + h * 64 + 32 + 8 * g4 + 4 * h2) = w1;
        }
    }
}

#define NA_STRIDE 144
#define NA_VS_OFF (64 * NA_STRIDE)
#define NA_RPB_OFF (2 * 64 * NA_STRIDE)
__device__ __forceinline__ void na_item(const Params& p, int layer, int item, bool ctxq, char* smem) {
    const int tid = otid(), wid = tid >> 6, lane = tid & 63, ql = lane & 15, g = lane >> 4;
    const bf16_t* P = p.R1_(); const bf16_t* VT = (const bf16_t*)(p.R3_() + R3_NAVT); bf16_t* MIX = p.R2_();
    char* KS = smem; char* VS = smem + NA_VS_OFF; float* RPB = (float*)(smem + NA_RPB_OFF);
    int b, r = 0, h, tkq;
    if (!ctxq) { h = item & 3; r = (item >> 2) & 31; b = item >> 7; tkq = b * SEQ + r * 64 + wid * 16 + ql; }
    else { h = item & 3; b = item >> 4; tkq = TL + b * CTXL + ((item >> 2) & 3) * 64 + wid * 16 + ql; }
    const int c = wid * 16 + ql;
    const int rs = min(max(r - 4, 0), 24), cs = min(max(c - 8, 0), 48);
    const int bs = wid == 0 ? 0 : (wid == 1 ? 8 : (wid == 2 ? 24 : 32));
    __syncthreads();
    if (!ctxq) {
        const float* rsrc = p.na_rpb + ((size_t)layer * 4 + h) * 465;
        const int i1 = min(tid + 256, 464);
        const float t0 = rsrc[tid], t1 = rsrc[i1];
        RPB[tid] = t0 * 1.4426950408889634f; RPB[i1] = t1 * 1.4426950408889634f;
    }
    bf16x8 qf[2];
#pragma unroll
    for (int s = 0; s < 2; ++s) qf[s] = *(const bf16x8*)(P + (size_t)tkq * PLD + PC_NAQ + h * 64 + 32 * s + 8 * g);
    f32x4 o[4];
#pragma unroll
    for (int dt = 0; dt < 4; ++dt) o[dt] = (f32x4){0.f, 0.f, 0.f, 0.f};
    float m = -1e30f, l = 0.f;
    const int nst = ctxq ? 4 : 12;
    u32x4 pk[2], pv[2];
    const char* kp[2]; const char* vp[2]; unsigned dst[2];
#pragma unroll
    for (int i = 0; i < 2; ++i) {
        const int piece = tid + 256 * i, rr = piece >> 3, c8 = piece & 7;
        kp[i] = (const char*)(P + (size_t)rr * PLD + PC_NAK + h * 64 + c8 * 8);
        vp[i] = (const char*)(VT + ((size_t)b * 256 + h * 64 + rr) * SEQA + c8 * 8);
        dst[i] = rr * NA_STRIDE + c8 * 16;
    }
    auto prefetch = [&](int st) {
        const bool win = !ctxq && st < 8;
        const int cst = ctxq ? st : st - 8;
        const unsigned tok0 = win ? b * SEQ + (rs + st) * 64 : TL + b * CTXL + cst * 64;
        const int seq0 = win ? (rs + st) * 64 : SEQ + cst * 64;
#pragma unroll
        for (int i = 0; i < 2; ++i) { pk[i] = *(const u32x4*)(kp[i] + (size_t)tok0 * (PLD * 2)); pv[i] = *(const u32x4*)(vp[i] + seq0 * 2); }
    };
    int boff[8];
#pragma unroll
    for (int i = 0; i < 4; ++i) {
        const int kc0 = bs + 4 * g + i, kc1 = kc0 + 16;
        boff[i] = (kc0 >= cs && kc0 < cs + 16) ? kc0 - c + 15 : -1;
        boff[4 + i] = (kc1 >= cs && kc1 < cs + 16) ? kc1 - c + 15 : -1;
    }
    prefetch(0);
    const char* KA = KS + ql * NA_STRIDE + 16 * g; const char* VA = VS + ql * NA_STRIDE + 8 * g;
    for (int st = 0; st < nst; ++st) {
        const bool win = !ctxq && st < 8;
        __syncthreads();
#pragma unroll
        for (int i = 0; i < 2; ++i) { *(u32x4*)(KS + dst[i]) = pk[i]; *(u32x4*)(VS + dst[i]) = pv[i]; }
        __syncthreads();
        if (st + 1 < nst) prefetch(st + 1);
        const int ngrp = win ? 1 : 2;
        for (int gi = 0; gi < ngrp; ++gi) {
            const int kb = win ? bs : gi * 32;
            const f32x4 z4 = (f32x4){0.f, 0.f, 0.f, 0.f};
            f32x4 s0 = __builtin_amdgcn_mfma_f32_16x16x32_bf16(*(const bf16x8*)(KA + kb * NA_STRIDE), qf[0], z4, 0, 0, 0);
            f32x4 s1 = __builtin_amdgcn_mfma_f32_16x16x32_bf16(*(const bf16x8*)(KA + (kb + 16) * NA_STRIDE), qf[0], z4, 0, 0, 0);
            s0 = __builtin_amdgcn_mfma_f32_16x16x32_bf16(*(const bf16x8*)(KA + kb * NA_STRIDE + 64), qf[1], s0, 0, 0, 0);
            s1 = __builtin_amdgcn_mfma_f32_16x16x32_bf16(*(const bf16x8*)(KA + (kb + 16) * NA_STRIDE + 64), qf[1], s1, 0, 0, 0);
            if (win) {
                const float* rp = RPB + (rs + st - r + 7) * 31;
                float bv[8];
#pragma unroll
                for (int i = 0; i < 8; ++i) bv[i] = rp[max(boff[i], 0)];
#pragma unroll
                for (int i = 0; i < 4; ++i) {
                    s0[i] = boff[i] >= 0 ? s0[i] + bv[i] : -1e30f;
                    s1[i] = boff[4 + i] >= 0 ? s1[i] + bv[4 + i] : -1e30f;
                }
            }
            float mx = fmaxf(fmaxf(fmaxf(s0[0], s0[1]), fmaxf(s0[2], s0[3])), fmaxf(fmaxf(s1[0], s1[1]), fmaxf(s1[2], s1[3])));
            mx = xh32_max(xh16_max(mx));
            if (__any(mx > m)) {
                const float mn = fmaxf(m, mx), al = __builtin_amdgcn_exp2f(m - mn);
                m = mn; l *= al;
#pragma unroll
                for (int dt = 0; dt < 4; ++dt) o[dt] *= al;
            }
            float rsum = 0.f;
#pragma unroll
            for (int i = 0; i < 4; ++i) { s0[i] = __builtin_amdgcn_exp2f(s0[i] - m); s1[i] = __builtin_amdgcn_exp2f(s1[i] - m); rsum += s0[i] + s1[i]; }
            rsum = xh32_sum(xh16_sum(rsum));
            l += rsum;
            union { bf16x8 v; unsigned u[4]; } pb;
            pb.u[0] = pk2(s0[0], s0[1]); pb.u[1] = pk2(s0[2], s0[3]); pb.u[2] = pk2(s1[0], s1[1]); pb.u[3] = pk2(s1[2], s1[3]);
#pragma unroll
            for (int dt = 0; dt < 4; ++dt) {
                union { bf16x8 v; unsigned u[4]; } a;
                const u32x2 x0 = *(const u32x2*)(VA + dt * 16 * NA_STRIDE + kb * 2), x1 = *(const u32x2*)(VA + dt * 16 * NA_STRIDE + (kb + 16) * 2);
                a.u[0] = x0.x; a.u[1] = x0.y; a.u[2] = x1.x; a.u[3] = x1.y;
                o[dt] = __builtin_amdgcn_mfma_f32_16x16x32_bf16(a.v, pb.v, o[dt], 0, 0, 0);
            }
        }
    }
    const float inv = 1.0f / l;
#pragma unroll
    for (int dt = 0; dt < 4; ++dt) {
        u32x2 w; w.x = pk2(o[dt][0] * inv, o[dt][1] * inv); w.y = pk2(o[dt][2] * inv, o[dt][3] * inv);
        *(u32x2*)(MIX + (size_t)tkq * 1024 + 256 + h * 64 + dt * 16 + 4 * g) = w;
    }
}

__device__ __forceinline__ void na_naive_item(const Params& p, int layer, int item, bool ctxq) {
    const int tid = otid(), h = tid >> 6, c = tid & 63;
    const bf16_t* P = p.R1_(); bf16_t* MIX = p.R2_();
    int b, r = 0, tk;
    if (!ctxq) { b = item >> 5; r = item & 31; tk = b * SEQ + r * 64 + c; }
    else { b = item >> 2; tk = TL + b * CTXL + (item & 3) * 64 + c; }
    float q[64], o[64];
    load_row_bf16_64(P + (size_t)tk * PLD + PC_NAQ + h * 64, q);
#pragma unroll
    for (int d = 0; d < 64; ++d) o[d] = 0.f;
    float m = -1e30f, l = 0.f;
    if (!ctxq) {
        const int rs = min(max(r - 4, 0), 24), cs = min(max(c - 8, 0), 48);
        const float* rpb = p.na_rpb + ((size_t)layer * 4 + h) * 15 * 31;
        for (int i = 0; i < 128; ++i) {
            const int kr = rs + (i >> 4), kc = cs + (i & 15);
            const int kt = b * SEQ + kr * 64 + kc;
            const float s = dot_row_bf16<64>(P + (size_t)kt * PLD + PC_NAK + h * 64, q, rpb[(kr - r + 7) * 31 + (kc - c + 15)]);
            const float mn = fmaxf(m, s), al = __expf(m - mn), pe = __expf(s - mn);
            l = l * al + pe; m = mn;
            axpy_row_bf16_64(P + (size_t)kt * PLD + PC_NAV + h * 64, o, al, pe);
        }
    }
    for (int i = 0; i < CTXL; ++i) {
        const int kt = TL + b * CTXL + i;
        const float s = dot_row_bf16<64>(P + (size_t)kt * PLD + PC_NAK + h * 64, q, 0.f);
        const float mn = fmaxf(m, s), al = __expf(m - mn), pe = __expf(s - mn);
        l = l * al + pe; m = mn;
        axpy_row_bf16_64(P + (size_t)kt * PLD + PC_NAV + h * 64, o, al, pe);
    }
    const float inv = 1.0f / l;
#pragma unroll
    for (int d = 0; d < 64; ++d) o[d] *= inv;
    store_row_bf16_64(MIX + (size_t)tk * 1024 + 256 + h * 64, o);
}

__device__ __forceinline__ void ret_naive_item(const Params& p, int layer, int item) {
    const int tid = otid(), h = tid >> 6, j = tid & 63;
    const bf16_t* P = p.R1_(); bf16_t* MIX = p.R2_();
    const int b = item / 36, grp = item % 36;
    const bool ctxq = grp >= 32;
    const int t = ctxq ? (grp - 32) * 64 + j : grp * 64 + j;
    const int tk = ctxq ? TL + b * CTXL + t : b * SEQ + t;
    const float lgf = p.ret_log_decay[(layer * 2 + 0) * 4 + h] * 1.4426950408889634f, lgb = p.ret_log_decay[(layer * 2 + 1) * 4 + h] * 1.4426950408889634f;
    float q[64], y[64];
    load_row_bf16_64(P + (size_t)tk * PLD + PC_RQ + h * 64, q);
#pragma unroll
    for (int d = 0; d < 64; ++d) y[d] = 0.f;
    if (!ctxq) {
        for (int s = 0; s < SEQ; ++s) {
            const int kt = b * SEQ + s;
            const float dot = dot_row_bf16<64>(P + (size_t)kt * PLD + PC_RK + h * 64, q, 0.f);
            const int n = t - s;
            const float w = dot * (n >= 0 ? exp2f(lgf * (float)n) : exp2f(lgb * (float)(-n)));
            axpy1_row_bf16_64(P + (size_t)kt * PLD + PC_RV + h * 64, y, w);
        }
    }
    for (int mI = 0; mI < CTXL; ++mI) {
        const int kt = TL + b * CTXL + mI;
        const float dot = dot_row_bf16<64>(P + (size_t)kt * PLD + PC_RK + h * 64, q, 0.f);
        float dec;
        if (!ctxq) dec = exp2f(lgf * (float)(t + CTXL - mI)) + exp2f(lgb * (float)(SEQ - t + mI));
        else { const int n = t - mI; dec = n >= 0 ? exp2f(lgf * (float)n) : exp2f(lgb * (float)(-n)); }
        const float w = dot * dec;
        axpy1_row_bf16_64(P + (size_t)kt * PLD + PC_RV + h * 64, y, w);
    }
    float mu = 0.f;
#pragma unroll
    for (int d = 0; d < 64; ++d) mu += y[d];
    mu *= (1.0f / 64.0f);
    float var = 0.f;
#pragma unroll
    for (int d = 0; d < 64; ++d) { y[d] -= mu; var += y[d] * y[d]; }
    const float rs = rsqrtf(var * (1.0f / 64.0f) + 1e-6f);
    float g[64];
    load_row_bf16_64(P + (size_t)tk * PLD + PC_RG + h * 64, g);
#pragma unroll
    for (int d = 0; d < 64; ++d) y[d] = silu_f(g[d]) * y[d] * rs;
    store_row_bf16_64(MIX + (size_t)tk * 1024 + 768 + h * 64, y);
}

__device__ __forceinline__ void s5_carry_item(const Params& p, int layer, int item) {
    const int gt = item * 256 + otid();
    const int pp = gt & 63, dir = (gt >> 6) & 1, g = (gt >> 7) & 15, b = gt >> 11;
    const float* PW = p.s5pw_() + ((((size_t)layer * 16 + g) * 2 + dir) * 33 + 32) * 128;
    const float ar = PW[pp * 2], ai = PW[pp * 2 + 1];
    const float* Sloc = (const float*)(p.R3_() + R3_S5SLOC); bf16_t* Hin = (bf16_t*)(p.R3_() + R3_S5HIN);
    float sr = 0.f, si = 0.f;
#pragma unroll 1
    for (int i0 = 0; i0 < S5NCH; i0 += 12) {
        float xr[12], xi[12];
#pragma unroll
        for (int j = 0; j < 12; ++j) {
            const int i = i0 + j;
            const int k = dir == 0 ? (i < 8 ? 64 + i : i - 8) : 71 - i;
            const size_t row = ((size_t)(b * S5NCH + k) * 16 + g) * 256 + dir * 128;
            xr[j] = __builtin_nontemporal_load(Sloc + row + pp); xi[j] = __builtin_nontemporal_load(Sloc + row + 64 + pp);
        }
#pragma unroll
        for (int j = 0; j < 12; ++j) {
            const int i = i0 + j;
            const int k = dir == 0 ? (i < 8 ? 64 + i : i - 8) : 71 - i;
            const size_t row = ((size_t)(b * S5NCH + k) * 16 + g) * 256 + dir * 128;
            Hin[row + pp] = f2bf(sr); Hin[row + 64 + pp] = f2bf(si);
            const float nr = ar * sr - ai * si + xr[j], ni = ar * si + ai * sr + xi[j];
            sr = nr; si = ni;
        }
    }
}

__device__ __forceinline__ void phase_mix(const Params& p, const int layer, char* smem) {
    const bool need_ctx = layer < DEPTH - 1;
    const int n_mla = 1024, n_mlac = need_ctx ? 128 : 0, n_ret = BATCH * 4 * 2 * 16, n_na = 4096, n_nac = need_ctx ? 512 : 0, n_s5 = 256;
    const int e0 = n_s5, e1 = e0 + n_mlac, e2 = e1 + n_mla, e3 = e2 + n_na, e4 = e3 + n_nac, e5 = e4 + n_ret;
    for (int it = VB; it < e5; it += NVB) {
        if (it < e0) s5_carry_item(p, layer, it);
        else if (it < e1) mla_item(p, it - e0, true, smem);
        else if (it < e2) mla_item(p, it - e1, false, smem);
        else if (it < e3) na_item(p, layer, it - e2, false, smem);
        else if (it < e4) na_item(p, layer, it - e3, true, smem);
        else ret_carry_item(p, layer, it - e4);
    }
}

__device__ __forceinline__ void phase_s5out(const Params& p, const int layer, char* smem) {
    GEMM_IDS
    const bf16_t* P = p.R1_(); const bf16_t* Hin = (const bf16_t*)(p.R3_() + R3_S5HIN); bf16_t* G = (bf16_t*)(p.R3_() + R3_S5G);
    const float* dsk = p.s5_d + layer * 256;
    const int nret2 = BATCH * 18 * 4;
    for (int it = VBX; it < 16 * 18 * 4 + nret2; it += NVB) {
        if (it >= 16 * 18 * 4) { const int j = it - 16 * 18 * 4; if (layer < DEPTH - 1 || ((j >> 2) % 18) < 16) ret_pass2_item(p, layer, j); continue; }
        const int g = it / 72, r2 = it % 72, mt = r2 >> 2, nt = r2 & 3;
        const bf16_t* Wo = p.s5wo_() + ((size_t)(layer * 16 + g) * 512) * 768;
        const int R0 = mt * 128 + (tid >> 2), R1 = R0 + 64;
        const int tb0 = s5_tokbase(R0), tb1 = s5_tokbase(R1);
        const bf16_t* UGg = p.UG_() + (size_t)g * TT * 16;
        f32x4 acc[4][4];
        gemm128<true, false>([&](int r, int k) { const int tb = r < 64 ? tb0 : tb1; const int R = r < 64 ? R0 : R1;
                                 return k < 512 ? UGg + (size_t)tb * 16 + k : Hin + ((size_t)R * 16 + g) * 256 + (k - 512); },
                             [&](int r, int k) { return Wo + (size_t)(nt * 128 + r) * 768 + k; }, 768, acc, smem);
        EPI_LOOP_T({
            const int R = mt * 128 + row, n = nt * 128 + col;
            const int tk = s5_tokbase(R) + (n >> 4), ch = g * 16 + (n & 15);
            const u32x2 uu = *(const u32x2*)(P + (size_t)tk * PLD + PC_U + ch);
            const f32x4 dd = *(const f32x4*)(dsk + ch);
            const float y0 = gelu_tanh(v[0] + dd[0] * lo2f(uu.x)), y1 = gelu_tanh(v[1] + dd[1] * hi2f(uu.x));
            const float y2 = gelu_tanh(v[2] + dd[2] * lo2f(uu.y)), y3 = gelu_tanh(v[3] + dd[3] * hi2f(uu.y));
            u32x2 w; w.x = pk2(y0, y1); w.y = pk2(y2, y3);
            *(u32x2*)(G + (size_t)tk * 256 + ch) = w;
        })
    }
}

__device__ __forceinline__ void phase_glu(const Params& p, const int layer, char* smem) {
    GEMM_IDS
    const bf16_t* G = (const bf16_t*)(p.R3_() + R3_S5G); bf16_t* MIX = p.R2_();
    const bf16_t* Wg = p.wglu_t_() + (size_t)layer * 256 * 256;
    const float* bg = p.s5_b_glu + layer * 256;
    const int nmt = layer < DEPTH - 1 ? 576 : 512;
    for (int it = VBX; it < nmt * 2; it += NVB) {
        const int mt = it >> 1, nt = it & 1;
        f32x4 acc[4][4];
        gemm128<true, false>([&](int r, int k) { return G + (size_t)(mt * 128 + r) * 256 + k; },
                             [&](int r, int k) { return Wg + (size_t)(nt * 128 + r) * 256 + k; }, 256, acc, smem);
        EPI_LOOP_T({
            const int tk = mt * 128 + row, n = nt * 128 + col;
            const u32x2 gg = *(const u32x2*)(G + (size_t)tk * 256 + n);
            const f32x4 bb = *(const f32x4*)(bg + n);
            u32x2 w; w.x = pk2(lo2f(gg.x) * sigmoid_f(v[0] + bb[0]), hi2f(gg.x) * sigmoid_f(v[1] + bb[1]));
            w.y = pk2(lo2f(gg.y) * sigmoid_f(v[2] + bb[2]), hi2f(gg.y) * sigmoid_f(v[3] + bb[3]));
            *(u32x2*)(MIX + (size_t)tk * 1024 + 512 + n) = w;
        })
    }
}

__device__ __forceinline__ void phase_wout(const Params& p, const int layer, LAS unsigned char* lds, char* smh) {
    const bf16_t* MIX = p.R2_();
    g8::StaticOrder S; S.init(layer < DEPTH - 1 ? TT : TL, 1024, gridDim.x, blockIdx.x);
    g8::gemm8(lds, MIX, p.wout_t_() + (size_t)layer * 1024 * 1024, 1024, S,
        [&](const g8::Unit& u, int row) { return (unsigned)((u.pm * 256 + row) * 2048); },
        [&](const g8::Unit& u) { return (size_t)u.pn * 256 * 2048; },
        [&](const f32x4 (&acc)[2][2][4][2], const g8::Unit& u, int wr, int wc, int fr, int fq) {
            bf16_t* WO = (bf16_t*)p.R3_();
#pragma unroll
            for (int ai = 0; ai < 2; ++ai)
#pragma unroll
                for (int m = 0; m < 4; ++m) {
                    const size_t tk = (size_t)u.pm * 256 + ai * 128 + wr * 64 + m * 16 + fr;
#pragma unroll
                    for (int bj = 0; bj < 2; ++bj)
#pragma unroll
                        for (int n = 0; n < 2; ++n) {
                            const f32x4 v = acc[ai][bj][m][n];
                            u32x2 w; w.x = pk2(v[0], v[1]); w.y = pk2(v[2], v[3]);
                            *(u32x2*)(WO + tk * 1024 + u.pn * 256 + bj * 128 + wc * 32 + n * 16 + fq * 4) = w;
                        }
                }
        });
    {
        const int nwg = ((layer < DEPTH - 1 ? TT : TL) / 256) * 4, rem = nwg % (int)gridDim.x;
        const int first = rem, nidle = (int)gridDim.x - rem;
        asm volatile("s_waitcnt vmcnt(0) lgkmcnt(0)" ::: "memory");
        if ((int)blockIdx.x >= first) {
            const int vb = ((int)blockIdx.x - first) * 2 + (rtid() >> 8), nvb = nidle * 2;
            moe_conv_range(p, layer, 4096 + vb, 6144, nvb, smh);
        }
    }
}

#define N2_LG_OFF 0
__device__ __forceinline__ void phase_norm2(const Params& p, const int layer, char* smem) {
    GEMM_IDS
    bf16_t* F = p.R1_();
    const int nmain = TL / 128, ntile = nmain + (layer < DEPTH - 1 ? TC / 16 : 0);
    const bf16_t* Wr = p.wr_t_() + (size_t)layer * 128 * 2048;
    float* LG = (float*)(smem + N2_LG_OFF);
    if (VB == 0) { unsigned z = 0u; asm volatile("" : "+v"(z)); u32x2 zz; zz.x = z; zz.y = z; *(u32x2*)(F + (size_t)TT * 1024 + tid * 4) = zz; }
    for (int it = VB; it < ntile; it += NVB) {
        const bool mini = it >= nmain;
        const int tok0 = mini ? TL + (it - nmain) * 16 : it * 128, nrows = mini ? 16 : 128, rpw = nrows >> 2;
        {
            const float* md = mod_row(p, layer, tok0);
            f32x4 ga[4], sh[4], gt[4];
#pragma unroll
            for (int i = 0; i < 4; ++i) {
                const int c = i * 256 + lane * 4;
                const f32x4 g = *(const f32x4*)(p.g_ffn + layer * 1024 + c), sc = *(const f32x4*)(md + 4096 + c);
                sh[i] = *(const f32x4*)(md + 3072 + c); gt[i] = *(const f32x4*)(md + 2048 + c);
                ga[i][0] = g[0] * (1.0f + sc[0]); ga[i][1] = g[1] * (1.0f + sc[1]); ga[i][2] = g[2] * (1.0f + sc[2]); ga[i][3] = g[3] * (1.0f + sc[3]);
            }
            bf16_t* XB = p.XB_();
            const bf16_t* WOb = (const bf16_t*)p.R3_();
            auto tail = [&](int tk, f32x4 (&vq)[4], const u32x2 (&woq)[4]) {
                float ss = 0.f;
#pragma unroll
                for (int i = 0; i < 4; ++i) {
                    vq[i][0] += gt[i][0] * lo2f(woq[i].x); vq[i][1] += gt[i][1] * hi2f(woq[i].x); vq[i][2] += gt[i][2] * lo2f(woq[i].y); vq[i][3] += gt[i][3] * hi2f(woq[i].y);
                    u32x2 xw; xw.x = pk2(vq[i][0], vq[i][1]); xw.y = pk2(vq[i][2], vq[i][3]);
                    __builtin_nontemporal_store(xw, (u32x2*)(XB + (size_t)tk * 1024 + i * 256 + lane * 4));
                    ss += vq[i][0] * vq[i][0] + vq[i][1] * vq[i][1] + vq[i][2] * vq[i][2] + vq[i][3] * vq[i][3];
                }
                ss = wave_sum(ss);
                const float rstd = rsqrtf(ss * (1.0f / 1024.0f) + 1e-6f);
#pragma unroll
                for (int i = 0; i < 4; ++i) {
                    const int c = i * 256 + lane * 4;
                    float f[4];
#pragma unroll
                    for (int j = 0; j < 4; ++j) f[j] = vq[i][j] * rstd * ga[i][j] + sh[i][j];
                    u32x2 w; w.x = pk2(f[0], f[1]); w.y = pk2(f[2], f[3]);
                    *(u32x2*)(F + (size_t)tk * 1024 + c) = w;
                }
            };
#pragma unroll 1
            for (int rr = 0; rr < rpw; rr += 4) {
                const int tkb = tok0 + wid * rpw + rr;
                if (layer == 0) {
                    f32x4 v[4][4]; u32x2 wo[4][4];
#pragma unroll
                    for (int q = 0; q < 4; ++q) {
                        const int tk = tkb + q;
                        const float* xin = tk < TL ? p.x + (size_t)tk * 1024 : p.ctx + (size_t)(tk - TL) * 1024;
#pragma unroll
                        for (int i = 0; i < 4; ++i) { v[q][i] = __builtin_nontemporal_load((const f32x4*)(xin + i * 256 + lane * 4)); wo[q][i] = __builtin_nontemporal_load((const u32x2*)(WOb + (size_t)tk * 1024 + i * 256 + lane * 4)); }
                    }
#pragma unroll
                    for (int q = 0; q < 4; ++q) tail(tkb + q, v[q], wo[q]);
                } else {
                    u32x2 xb[4][4], wo[4][4];
#pragma unroll
                    for (int q = 0; q < 4; ++q) {
                        const int tk = tkb + q;
#pragma unroll
                        for (int i = 0; i < 4; ++i) { xb[q][i] = __builtin_nontemporal_load((const u32x2*)(XB + (size_t)tk * 1024 + i * 256 + lane * 4)); wo[q][i] = __builtin_nontemporal_load((const u32x2*)(WOb + (size_t)tk * 1024 + i * 256 + lane * 4)); }
                    }
#pragma unroll
                    for (int q = 0; q < 4; ++q) {
                        f32x4 vq[4];
#pragma unroll
                        for (int i = 0; i < 4; ++i) vq[i] = (f32x4){lo2f(xb[q][i].x), hi2f(xb[q][i].x), lo2f(xb[q][i].y), hi2f(xb[q][i].y)};
                        tail(tkb + q, vq, wo[q]);
                    }
                }
            }
        }
        asm volatile("s_waitcnt vmcnt(0)" ::: "memory");
        __syncthreads();
        f32x4 acc[4][4];
        gemm128<true, false>([&](int r, int k) { return F + (size_t)(tok0 + (r < nrows ? r : 0)) * 1024 + k; },
                             [&](int r, int k) { return Wr + (size_t)r * 2048 + k; }, 1024, acc, smem);
#pragma unroll
        for (int m_ = 0; m_ < 4; ++m_)
#pragma unroll
            for (int n_ = 0; n_ < 4; ++n_) {
                const int row = wr * 64 + m_ * 16 + fr, col = wc * 64 + n_ * 16 + fq * 4;
                if (col < 72) *(f32x4*)(LG + row * 72 + col) = acc[m_][n_];
            }
        __syncthreads();
        int re0 = 0, re1 = 0; float rg0 = 0.f, rg1 = 0.f;
        if (tid < nrows) {
            float* lg = LG + tid * 72;
#pragma unroll
            for (int q = 0; q < 36; ++q) lg[q] += lg[36 + q];
            float gl[4]; int gi = 0; float gm = -3.0e38f;
#pragma unroll
            for (int q = 0; q < 4; ++q) { gl[q] = lg[q] + p.moe_b_group[layer * 4 + q]; if (gl[q] > gm) { gm = gl[q]; gi = q; } }
            float gs = 0.f;
#pragma unroll
            for (int q = 0; q < 4; ++q) gs += __expf(gl[q] - gm);
            const float ggate = 1.0f / gs;
            float el[8]; float em = -3.0e38f;
#pragma unroll
            for (int q = 0; q < 8; ++q) { el[q] = lg[4 + gi * 8 + q] + p.moe_b_expert[layer * 32 + gi * 8 + q]; em = fmaxf(em, el[q]); }
            int i0 = 0; float b0 = -3.0e38f;
#pragma unroll
            for (int q = 0; q < 8; ++q) if (el[q] > b0) { b0 = el[q]; i0 = q; }
            int i1 = 0; float b1 = -3.0e38f;
#pragma unroll
            for (int q = 0; q < 8; ++q) if (q != i0 && el[q] > b1) { b1 = el[q]; i1 = q; }
            const float p0 = __expf(b0 - em), p1 = __expf(b1 - em);
            const float g0 = ggate * p0 / (p0 + p1), g1 = ggate * p1 / (p0 + p1);
            const int e0 = gi * 8 + i0, e1 = gi * 8 + i1;
            re0 = e0; re1 = e1; rg0 = g0; rg1 = g1;
        }
        int* lc = (int*)(LG + 128 * 72); int* lbase = lc + 32;
        if (tid < 32) lc[tid] = 0;
        __syncthreads();
        int r0 = 0, r1 = 0;
        if (tid < nrows) { r0 = atomicAdd(lc + re0, 1); r1 = atomicAdd(lc + re1, 1); }
        __syncthreads();
        if (tid < 32) { const int c = lc[tid]; lbase[tid] = c > 0 ? atomicAdd(p.ecnt_() + (layer * 32 + tid) * 64, c) : 0; }
        __syncthreads();
        if (tid < nrows) {
            const int tk = tok0 + tid;
            const int q0 = lbase[re0] + r0, q1 = lbase[re1] + r1;
            p.elist_()[(size_t)re0 * TT + q0] = tk; p.elist_()[(size_t)re1 * TT + q1] = tk;
            p.route_e_()[tk * 2] = re0; p.route_e_()[tk * 2 + 1] = re1; p.route_p_()[tk * 2] = q0; p.route_p_()[tk * 2 + 1] = q1;
            p.route_g_()[tk * 2] = rg0; p.route_g_()[tk * 2 + 1] = rg1;
        }
        __syncthreads();
    }
}

struct MoeOrder {
    int G, c, nunits;
    __device__ bool next(int i, g8::Unit& u) const { const int L = i * G + c; if (L >= nunits) return false; u.pm = L >> 2; u.pn = L & 3; return true; }
};
struct ExpTab {
    int cntv, pblkv, total;
    __device__ __forceinline__ void init(const Params& p, int layer) {
        int tq = threadIdx.x; asm volatile("" : "+v"(tq)); const int ln = tq & 63;
        cntv = ln < 32 ? p.ecnt_()[(layer * 32 + ln) * 64] : 0;
        const int nb = (cntv + 255) >> 8;
        int inc = nb;
#pragma unroll
        for (int o = 1; o < 32; o <<= 1) { const int t = __builtin_amdgcn_ds_bpermute(((ln - o) & 63) << 2, inc); if (ln >= o) inc += t; }
        pblkv = inc - nb;
        total = __builtin_amdgcn_readlane(inc, 31);
    }
    __device__ __forceinline__ int expert(int rb) const {
        int tq = threadIdx.x; asm volatile("" : "+v"(tq)); const int ln = tq & 63;
        return __popcll(__ballot(ln >= 1 && ln < 32 && pblkv <= rb));
    }
    __device__ __forceinline__ int first_block(int e) const { return __builtin_amdgcn_readlane(pblkv, e); }
    __device__ __forceinline__ int count(int e) const { return __builtin_amdgcn_readlane(cntv, e); }
};
__device__ __forceinline__ void phase_moe1(const Params& p, const int layer, LAS unsigned char* lds) {
    ExpTab T; T.init(p, layer);
    const bf16_t* F = p.R1_(); bf16_t* HID = p.R1_() + HID_OFF_ELEMS;
    g8::StaticOrder S; S.init(T.total * 256, 1024, gridDim.x, blockIdx.x);
    g8::gemm8(lds, F, p.w13_t_(), 1024, S,
        [&](const g8::Unit& u, int row) { const int e = T.expert(u.pm), idx = (u.pm - T.first_block(e)) * 256 + row;
                                          const int tok = idx < T.count(e) ? p.elist_()[(size_t)e * TT + idx] : TT; return (unsigned)tok * 2048u; },
        [&](const g8::Unit& u) { return ((size_t)T.expert(u.pm) * 1024 + u.pn * 256) * 2048; },
        [&](const f32x4 (&acc)[2][2][4][2], const g8::Unit& u, int wr, int wc, int fr, int fq) {
#pragma unroll
            for (int ai = 0; ai < 2; ++ai)
#pragma unroll
                for (int m = 0; m < 4; ++m) {
                    const size_t slot = (size_t)u.pm * 256 + ai * 128 + wr * 64 + m * 16 + fr;
#pragma unroll
                    for (int bj = 0; bj < 2; ++bj) {
                        const f32x4 a = acc[ai][bj][m][0], b = acc[ai][bj][m][1];
                        const int j = (u.pn * 8 + bj * 4 + wc) * 16 + fq * 4;
                        u32x2 w; w.x = pk2(silu_f(a[0]) * b[0], silu_f(a[1]) * b[1]); w.y = pk2(silu_f(a[2]) * b[2], silu_f(a[3]) * b[3]);
                        *(u32x2*)(HID + slot * 512 + j) = w;
                    }
                    asm volatile("" ::: "memory");
                }
        });
}
__device__ __forceinline__ void phase_moe2(const Params& p, const int layer, LAS unsigned char* lds) {
    ExpTab T; T.init(p, layer);
    const bf16_t* HID = p.R1_() + HID_OFF_ELEMS; bf16_t* Y = (bf16_t*)p.R3_();
    g8::StaticOrder S; S.init(T.total * 256, 1024, gridDim.x, blockIdx.x);
    g8::gemm8(lds, HID, p.w2_t_(), 512, S,
        [&](const g8::Unit& u, int row) { return (unsigned)((u.pm * 256 + row) * 1024); },
        [&](const g8::Unit& u) { return ((size_t)T.expert(u.pm) * 1024 + u.pn * 256) * 1024; },
        [&](const f32x4 (&acc)[2][2][4][2], const g8::Unit& u, int wr, int wc, int fr, int fq) {
#pragma unroll
            for (int ai = 0; ai < 2; ++ai)
#pragma unroll
                for (int m = 0; m < 4; ++m) {
                    const size_t slot = (size_t)u.pm * 256 + ai * 128 + wr * 64 + m * 16 + fr;
#pragma unroll
                    for (int bj = 0; bj < 2; ++bj)
#pragma unroll
                        for (int n = 0; n < 2; ++n) {
                            const f32x4 v = acc[ai][bj][m][n];
                            u32x2 w; w.x = pk2(v[0], v[1]); w.y = pk2(v[2], v[3]);
                            *(u32x2*)(Y + slot * 1024 + u.pn * 256 + bj * 128 + wc * 32 + n * 16 + fq * 4) = w;
                        }
                    asm volatile("" ::: "memory");
                }
        });
}

#define HALF_LDS 66560
#define DYN_LDS (131072 + 512 + 18432 + 256)
__global__ void __launch_bounds__(512, 2) fwd_kernel(const Params p) {
    extern __shared__ __attribute__((aligned(16))) char smem_all[];
#define smem (smem_all + (rtid() >> 8) * HALF_LDS)
    volatile LAS unsigned* xbw = (volatile LAS unsigned*)(smem_all + DYN_LDS - 16);
    if (threadIdx.x == 0) { xbw[0] = 0u; xbw[1] = 0u; xbw[2] = 0u; xbw[3] = 0u; }
    __syncthreads();
    XcdBarrier bar = xcd_barrier_post(p.bar_(), xbw);
#ifndef ONLY
#define ONLY -1
#endif
#define RUN(id, call) if (ONLY < 0 || ONLY == id) { call; xcd_barrier(bar); }
    RUN(0, phase_pa(p, smem))
    RUN(1, phase_pb(p))
    RUN(2, phase_pc(p))
    for (int layer = 0; layer < DEPTH; ++layer) {
        RUN(3, phase_norm1(p, layer, smem))
        RUN(4, phase_win(p, layer, (LAS unsigned char*)smem_all, smem))
        RUN(5, phase_up(p, layer, smem))
        RUN(6, phase_mix(p, layer, smem))
        RUN(7, phase_s5out(p, layer, smem))
        RUN(8, phase_glu(p, layer, smem))
        RUN(9, phase_wout(p, layer, (LAS unsigned char*)smem_all, smem))
        RUN(10, phase_norm2(p, layer, smem))
        RUN(11, phase_moe1(p, layer, (LAS unsigned char*)smem_all))
        RUN(12, phase_moe2(p, layer, (LAS unsigned char*)smem_all))
    }
    phase_norm1(p, DEPTH, smem);
}

static inline size_t al256(size_t v) { return (v + 255) & ~(size_t)255; }
extern "C" void kernel_launch(void* const* d_in, const int* in_sizes, int n_in, void* d_out, int out_size, void* d_ws, size_t ws_size, hipStream_t stream) {
    (void)in_sizes; (void)n_in; (void)out_size;
    Params p{};
    const float* const* in = (const float* const*)d_in;
    p.x = in[0]; p.c = in[1]; p.ctx = in[2]; p.c_ctx = in[3]; p.w_mod = in[4]; p.b_mod = in[5]; p.g_mix = in[6]; p.g_ffn = in[7]; p.w_in = in[8];
    p.mla_g_cq = in[9]; p.mla_g_ckv = in[10]; p.mla_w_uq = in[11]; p.mla_w_ukv = in[12]; p.na_rpb = in[13];
    p.s5_a_re = in[14]; p.s5_a_im = in[15]; p.s5_log_dt = in[16]; p.s5_b_re = in[17]; p.s5_b_im = in[18]; p.s5_c_re = in[19]; p.s5_c_im = in[20];
    p.s5_d = in[21]; p.s5_w_glu = in[22]; p.s5_b_glu = in[23]; p.ret_log_decay = in[24]; p.w_out = in[25];
    p.moe_w_group = in[26]; p.moe_b_group = in[27]; p.moe_w_expert = in[28]; p.moe_b_expert = in[29]; p.moe_w1 = in[30]; p.moe_w3 = in[31]; p.moe_w2 = in[32]; p.g_final = in[33];
    p.out = (float*)d_out;
    p.ws = (char*)d_ws;
    char* ctrl = p.ws;
    const size_t off = WS_TOTAL;
    if (off > ws_size) return;
    static int grid = 0;
    if (!grid) {
        int dev = 0, cus = 0, per_cu = 0;
        hipGetDevice(&dev);
        hipDeviceGetAttribute(&cus, hipDeviceAttributeMultiprocessorCount, dev);
        hipFuncSetAttribute((const void*)fwd_kernel, hipFuncAttributeMaxDynamicSharedMemorySize, DYN_LDS);
        hipOccupancyMaxActiveBlocksPerMultiprocessor(&per_cu, fwd_kernel, 512, DYN_LDS);
        if (per_cu < 1) per_cu = 1;
        grid = cus * (per_cu < 1 ? per_cu : 1);
    }
    hipMemsetAsync(ctrl, 0, 65536, stream);
    hipLaunchKernelGGL(fwd_kernel, dim3(grid), dim3(512), DYN_LDS, stream, p);
}
```
